# Optimizing an MI355X kernel written in HIP

```python
import math
import jax, jax.numpy as jnp
from jax import lax
import numpy as np

D_MODEL = 4096
BATCH = 4
SEQ = 4096
DEPTH = 1

CHUNK = 64
Q_BLOCK = 128
HEAD_DIM = 128
N_FOX_HEADS = D_MODEL // 256
N_DIFF_HEADS = D_MODEL // 512
FOX_WIDTH = N_FOX_HEADS * HEAD_DIM
DIFF_WIDTH = N_DIFF_HEADS * 2 * HEAD_DIM
D_FF = ((8 * D_MODEL // 3 + 255) // 256) * 256
ROPE_THETA = 500000.0
ROPE_DIM = HEAD_DIM // 4
N_MOD = 9
EPS = 1e-6
IN_SIZES = (FOX_WIDTH, FOX_WIDTH, FOX_WIDTH, N_FOX_HEADS,
            DIFF_WIDTH, DIFF_WIDTH, DIFF_WIDTH, D_MODEL, D_MODEL)
IN_COLS = 3 * FOX_WIDTH + N_FOX_HEADS + 3 * DIFF_WIDTH + 2 * D_MODEL

kernel_name = 'hybrid_fox_diff_macaron_adaln_block'


def rms_norm(x, g):
    xf = x.astype(jnp.float32)
    y = xf * lax.rsqrt(jnp.mean(xf * xf, axis=-1, keepdims=True) + EPS)
    return (y * g.astype(jnp.float32)).astype(x.dtype)


def modulate(h, shift, scale):
    return h * (1 + scale[:, None, :]) + shift[:, None, :]


def swiglu(h, w_in, w_out):
    gate, up = jnp.split(h @ w_in, 2, axis=-1)
    return (jax.nn.silu(gate) * up) @ w_out


def rope_tables(positions):
    inv_freq = ROPE_THETA ** (-jnp.arange(0, ROPE_DIM, 2, dtype=jnp.float32) / ROPE_DIM)
    ang = positions.astype(jnp.float32)[..., None] * inv_freq
    return jnp.cos(ang), jnp.sin(ang)


def apply_partial_rope(t, cos, sin):
    cos = cos[:, :, None, None, :]
    sin = sin[:, :, None, None, :]
    half = ROPE_DIM // 2
    r1 = t[..., :half].astype(jnp.float32)
    r2 = t[..., half:ROPE_DIM].astype(jnp.float32)
    rotated = jnp.concatenate([r1 * cos - r2 * sin, r2 * cos + r1 * sin], axis=-1).astype(t.dtype)
    return jnp.concatenate([rotated, t[..., ROPE_DIM:]], axis=-1)


def fox_attention(q, k, v, log_f_cum):
    S = q.shape[2]
    scale = q.shape[-1] ** -0.5
    outs = []
    for i in range(S // Q_BLOCK):
        q0, q1 = i * Q_BLOCK, (i + 1) * Q_BLOCK
        logits = jnp.einsum('bhqd,bhkd->bhqk', q[:, :, q0:q1], k[:, :, :q1],
                            preferred_element_type=jnp.float32) * scale
        logits = logits + log_f_cum[:, :, q0:q1, None] - log_f_cum[:, :, None, :q1]
        t_idx = jnp.arange(q0, q1)[:, None]
        s_idx = jnp.arange(q1)[None, :]
        logits = jnp.where(s_idx <= t_idx, logits, -jnp.inf)
        p = jax.nn.softmax(logits, axis=-1)
        outs.append(jnp.einsum('bhqk,bhkd->bhqd', p.astype(v.dtype), v[:, :, :q1]))
    return jnp.concatenate(outs, axis=2)


def diff_attention(q, k, v, lam):
    S = q.shape[3]
    scale = q.shape[-1] ** -0.5
    outs = []
    for i in range(S // Q_BLOCK):
        q0, q1 = i * Q_BLOCK, (i + 1) * Q_BLOCK
        logits = jnp.einsum('bhnqd,bhnkd->bhnqk', q[:, :, :, q0:q1], k[:, :, :, :q1],
                            preferred_element_type=jnp.float32) * scale
        t_chunk = jnp.arange(q0, q1)[:, None] // CHUNK
        s_chunk = jnp.arange(q1)[None, :] // CHUNK
        logits = jnp.where(s_chunk <= t_chunk, logits, -jnp.inf)
        p = jax.nn.softmax(logits, axis=-1)
        attn = p[:, :, 0] - lam * p[:, :, 1]
        outs.append(jnp.einsum('bhqk,bhkd->bhqd', attn.astype(v.dtype), v[:, :, :q1]))
    return jnp.concatenate(outs, axis=2)


def setup_inputs(seed: int = 0) -> dict:
    key = jax.random.key(seed)
    ks = jax.random.split(key, 24)
    f32 = jnp.float32

    def w(k, shape, fan_in):
        return jax.random.normal(k, shape, f32) * (fan_in ** -0.5)

    def gain(k, shape):
        return 1.0 + 0.1 * jax.random.normal(k, shape, f32)

    def small(k, shape, s=0.02):
        return s * jax.random.normal(k, shape, f32)

    x = jax.random.normal(ks[0], (BATCH, SEQ, D_MODEL), f32)
    c = jax.random.normal(ks[1], (BATCH, D_MODEL), f32)
    offsets = jax.random.randint(ks[2], (BATCH, 1), 0, 16, dtype=jnp.int32) * CHUNK
    positions = (offsets + jnp.arange(SEQ, dtype=jnp.int32)[None, :]).astype(jnp.int32)
    return {
        'x': x,
        'c': c,
        'positions': positions,
        'ada_w': w(ks[3], (DEPTH, D_MODEL, N_MOD * D_MODEL), D_MODEL),
        'ada_b': small(ks[4], (DEPTH, N_MOD * D_MODEL)),
        'norm_ffn1': gain(ks[5], (DEPTH, D_MODEL)),
        'ffn1_w_in': w(ks[6], (DEPTH, D_MODEL, 2 * D_FF), D_MODEL),
        'ffn1_w_out': w(ks[7], (DEPTH, D_FF, D_MODEL), D_FF),
        'norm_mix': gain(ks[8], (DEPTH, D_MODEL)),
        'w_in': w(ks[9], (DEPTH, D_MODEL, IN_COLS), D_MODEL),
        'b_forget': 2.0 + 0.5 * jax.random.normal(ks[10], (DEPTH, N_FOX_HEADS), f32),
        'b_gate': small(ks[11], (DEPTH, 2 * D_MODEL), 0.1),
        'diff_lambda': 0.1 * jax.random.normal(ks[12], (DEPTH, 4, HEAD_DIM), f32),
        'diff_subln': gain(ks[13], (DEPTH, 2 * HEAD_DIM)),
        'w_o_fox': w(ks[14], (DEPTH, FOX_WIDTH, D_MODEL), FOX_WIDTH),
        'w_o_diff': w(ks[15], (DEPTH, DIFF_WIDTH, D_MODEL), DIFF_WIDTH),
        'w_out': w(ks[16], (DEPTH, D_MODEL, D_MODEL), D_MODEL),
        'norm_ffn2': gain(ks[17], (DEPTH, D_MODEL)),
        'ffn2_w_in': w(ks[18], (DEPTH, D_MODEL, 2 * D_FF), D_MODEL),
        'ffn2_w_out': w(ks[19], (DEPTH, D_FF, D_MODEL), D_FF),
        'final_ada_w': w(ks[20], (D_MODEL, 2 * D_MODEL), D_MODEL),
        'final_ada_b': small(ks[21], (2 * D_MODEL,)),
        'norm_final': gain(ks[22], (D_MODEL,)),
    }


def reference(x, c, positions, ada_w, ada_b, norm_ffn1, ffn1_w_in, ffn1_w_out, norm_mix,
              w_in, b_forget, b_gate, diff_lambda, diff_subln, w_o_fox, w_o_diff, w_out,
              norm_ffn2, ffn2_w_in, ffn2_w_out, final_ada_w, final_ada_b, norm_final):
    B, S, D = x.shape
    sc = jax.nn.silu(c)
    cos, sin = rope_tables(positions)
    split_points = []
    acc = 0
    for size in IN_SIZES[:-1]:
        acc += size
        split_points.append(acc)

    for l in range(DEPTH):
        lambda_init = 0.8 - 0.6 * math.exp(-0.3 * l)
        mod = sc @ ada_w[l] + ada_b[l]
        sh1, sc1, g1, sh2, sc2, g2, sh3, sc3, g3 = jnp.split(mod, N_MOD, axis=-1)

        h = modulate(rms_norm(x, norm_ffn1[l]), sh1, sc1)
        x = x + 0.5 * g1[:, None, :] * swiglu(h, ffn1_w_in[l], ffn1_w_out[l])

        h = modulate(rms_norm(x, norm_mix[l]), sh2, sc2)
        proj = h @ w_in[l]
        fq, fk, fv, ff, dq, dk, dv, ga, gb = jnp.split(proj, split_points, axis=-1)

        qa = fq.reshape(B, S, N_FOX_HEADS, HEAD_DIM).transpose(0, 2, 1, 3)
        ka = fk.reshape(B, S, N_FOX_HEADS, HEAD_DIM).transpose(0, 2, 1, 3)
        va = fv.reshape(B, S, N_FOX_HEADS, HEAD_DIM).transpose(0, 2, 1, 3)
        log_f = jax.nn.log_sigmoid(ff.astype(jnp.float32) + b_forget[l].astype(jnp.float32))
        log_f_cum = jnp.cumsum(log_f, axis=1).transpose(0, 2, 1)
        ya = fox_attention(qa, ka, va, log_f_cum)
        ya = ya.transpose(0, 2, 1, 3).reshape(B, S, FOX_WIDTH)

        qb = apply_partial_rope(dq.reshape(B, S, N_DIFF_HEADS, 2, HEAD_DIM), cos, sin)
        kb = apply_partial_rope(dk.reshape(B, S, N_DIFF_HEADS, 2, HEAD_DIM), cos, sin)
        qb = qb.transpose(0, 2, 3, 1, 4)
        kb = kb.transpose(0, 2, 3, 1, 4)
        vb = dv.reshape(B, S, N_DIFF_HEADS, 2 * HEAD_DIM).transpose(0, 2, 1, 3)
        lam_p = diff_lambda[l].astype(jnp.float32)
        lam = (jnp.exp(jnp.sum(lam_p[0] * lam_p[1])) - jnp.exp(jnp.sum(lam_p[2] * lam_p[3]))
               + lambda_init)
        yb = diff_attention(qb, kb, vb, lam)
        yb = rms_norm(yb, diff_subln[l]) * (1 - lambda_init)
        yb = yb.transpose(0, 2, 1, 3).reshape(B, S, DIFF_WIDTH)

        gate_a, gate_b = jnp.split(jnp.concatenate([ga, gb], axis=-1) + b_gate[l], 2, axis=-1)
        merged = jax.nn.sigmoid(gate_a) * (ya @ w_o_fox[l]) + jax.nn.sigmoid(gate_b) * (yb @ w_o_diff[l])
        x = x + g2[:, None, :] * (merged @ w_out[l])

        h = modulate(rms_norm(x, norm_ffn2[l]), sh3, sc3)
        x = x + 0.5 * g3[:, None, :] * swiglu(h, ffn2_w_in[l], ffn2_w_out[l])

    shf, scf = jnp.split(sc @ final_ada_w + final_ada_b, 2, axis=-1)
    return modulate(rms_norm(x, norm_final), shf, scf)
```

```cpp
#include <hip/hip_runtime.h>
#include <hip/hip_bf16.h>
#include <cstdio>
#include <cstdint>
namespace pg8 {
#define PG8_LAS __attribute__((address_space(3)))
typedef unsigned short bf16_t;
typedef short bf16x8 __attribute__((ext_vector_type(8)));
typedef float f32x4 __attribute__((ext_vector_type(4)));
typedef unsigned u32x4 __attribute__((ext_vector_type(4)));
constexpr int BM = 256, BK = 64, HALF = 128, HTB = HALF * BK * 2  , STAGE_BYTES = 8 * HTB, NXCD = 8, WGM = 8;

__host__ __device__ __forceinline__ int lds_byte(int r, int c) { const int st = (r >> 4) * 2 + (c >> 5), rr = r & 15, cc = c & 31, ob = rr * 64 + cc * 2; return st * 1024 + (ob ^ (((ob >> 9) & 1) << 5)); }
__host__ __device__ __forceinline__ void stage_rc(int b, int& R, int& C) { const int st = b / 1024, sb = b % 1024, swz = sb ^ (((sb >> 9) & 1) << 5); R = (st >> 1) * 16 + swz / 64; C = (st & 1) * 32 + (swz % 64) / 2; }
__host__ __device__ __forceinline__ int perm32(int rho) { const int n = rho >> 4, i = rho & 15; return 8 * (i >> 2) + 4 * n + (i & 3); }

struct Unit { int pm, pn; };
struct Gemm { const bf16_t* A; const bf16_t* Bt; int M, N, K; };

struct StaticOrder {
    int nM, nN, nwg, G, c;
    __host__ __device__ void init(int M, int N, int G_, int c_) { nM = M / BM; nN = N / BM; nwg = nM * nN; G = G_; c = c_; }
    __host__ __device__ bool next(int i, Unit& u) const {
        const long L = (long)i * G + c; if (L >= nwg) return false;
        int wgid = (int)L; { const int q = nwg / NXCD, r = nwg % NXCD, xcd = wgid % NXCD, off = wgid / NXCD; wgid = (xcd < r ? xcd * (q + 1) : r * (q + 1) + (xcd - r) * q) + off; }
        const int nig = WGM * nN, gid = wgid / nig, fm = gid * WGM, gsz = (nM - fm) < WGM ? (nM - fm) : WGM;
        u.pm = fm + ((wgid % nig) % gsz); u.pn = (wgid % nig) / gsz; return true;
    }
    __device__ __forceinline__ void a_ready(const Unit&) const {}
    __device__ __forceinline__ void done(const Unit&) const {}
};
typedef __bf16 bf16x2_t __attribute__((ext_vector_type(2)));
typedef float f32x2_t __attribute__((ext_vector_type(2)));
__device__ __forceinline__ unsigned cvt_pk_bf16(float lo, float hi) { const f32x2_t v = {lo, hi}; const bf16x2_t b = __builtin_convertvector(v, bf16x2_t); return __builtin_bit_cast(unsigned, b); }
typedef float f32x2 __attribute__((ext_vector_type(2)));
__device__ __forceinline__ float sigm(float x) { return __builtin_amdgcn_rcpf(1.f + __builtin_amdgcn_exp2f(-1.4426950408889634f * x)); }
__device__ __forceinline__ u32x4 pack8(f32x4 a, f32x4 b) { u32x4 w; w.x = cvt_pk_bf16(a[0], a[1]); w.y = cvt_pk_bf16(a[2], a[3]); w.z = cvt_pk_bf16(b[0], b[1]); w.w = cvt_pk_bf16(b[2], b[3]); return w; }
__device__ __forceinline__ void unpack8(u32x4 w, f32x4& a, f32x4& b) {
    a[0] = __builtin_bit_cast(float, w.x << 16); a[1] = __builtin_bit_cast(float, w.x & 0xffff0000u); a[2] = __builtin_bit_cast(float, w.y << 16); a[3] = __builtin_bit_cast(float, w.y & 0xffff0000u);
    b[0] = __builtin_bit_cast(float, w.z << 16); b[1] = __builtin_bit_cast(float, w.z & 0xffff0000u); b[2] = __builtin_bit_cast(float, w.w << 16); b[3] = __builtin_bit_cast(float, w.w & 0xffff0000u); }

struct EpiSwiGLU {
    static constexpr bool PERM = true, AFTER_DRAIN = false;
    bf16_t* O; int ldc;
    __device__ __forceinline__ void operator()(const f32x4 (&acc)[2][2][4][2], const Unit& u, int wr, int wc, int fr, int fq) const {
        const int row0 = u.pm * BM + wr * 64 + fr, col0 = u.pn * HALF + wc * 32 + 8 * fq;
#pragma unroll
        for (int ai = 0; ai < 2; ++ai)
#pragma unroll
            for (int m = 0; m < 4; ++m) { bf16_t* rowp = O + (size_t)(row0 + ai * HALF + m * 16) * ldc + col0;
                f32x4 v[2];
#pragma unroll
                for (int n = 0; n < 2; ++n) { const f32x4 g = acc[ai][0][m][n], up = acc[ai][1][m][n];
#pragma unroll
                    for (int i = 0; i < 4; ++i) v[n][i] = g[i] * up[i] * sigm(g[i]); }
                *(u32x4*)rowp = pack8(v[0], v[1]); }
    }
};

struct EpiResid {
    static constexpr bool PERM = false, AFTER_DRAIN = false;
    const float* R; float* C; const float* gv;
    __device__ __forceinline__ void operator()(const f32x4 (&acc)[2][2][4][2], const Unit& u, int wr, int wc, int fr, int fq) const {
        const int row0 = u.pm * BM + wr * 64 + fr, col0 = u.pn * BM + wc * 32 + 4 * fq; const int b = u.pm >> 4;
        f32x4 g[2][2];
#pragma unroll
        for (int bj = 0; bj < 2; ++bj)
#pragma unroll
            for (int n = 0; n < 2; ++n) g[bj][n] = *(const f32x4*)(gv + b * 4096 + col0 + bj * HALF + n * 16);
#pragma unroll
        for (int ai = 0; ai < 2; ++ai)
#pragma unroll
            for (int m = 0; m < 4; ++m) { const size_t off = (size_t)(row0 + ai * HALF + m * 16) * 4096 + col0;
#pragma unroll
                for (int bj = 0; bj < 2; ++bj)
#pragma unroll
                    for (int n = 0; n < 2; ++n) { const f32x4 r = *(const f32x4*)(R + off + bj * HALF + n * 16); *(f32x4*)(C + off + bj * HALF + n * 16) = r + g[bj][n] * acc[ai][bj][m][n]; } }
    }
};

struct EpiProj {
    static constexpr bool PERM = true, AFTER_DRAIN = false;
    bf16_t* qkv; bf16_t* gates; const float* bgate; const float* ropec; const float* ropes;
    __device__ __forceinline__ void operator()(const f32x4 (&acc)[2][2][4][2], const Unit& u, int wr, int wc, int fr, int fq) const {
        const int t = u.pn >> 3, b = u.pm >> 4, s0 = (u.pm & 15) * 256 + wr * 64 + fr;
#if defined(ST_NOQKV) && ST_NOQKV
        if (t < 6) return;
#endif
        if (t < 6) {
            bf16_t* base = qkv + (size_t)t * ((size_t)16384 * 2048);
            const bool rope = (t == 3 || t == 4) && wc == 0;
#pragma unroll
            for (int bj = 0; bj < 2; ++bj) { const int head = (u.pn & 7) * 2 + bj; bf16_t* hb = base + (size_t)(b * 16 + head) * 4096 * 128;
#pragma unroll
                for (int ai = 0; ai < 2; ++ai)
#pragma unroll
                    for (int m = 0; m < 4; ++m) { const int s = s0 + ai * HALF + m * 16; bf16_t* p = hb + (size_t)s * 128;
                        const f32x4 v0 = acc[ai][bj][m][0], v1 = acc[ai][bj][m][1];
                        if (rope) { const size_t ri = ((size_t)b * 4096 + s) * 16 + 4 * fq; const f32x4 cs = *(const f32x4*)(ropec + ri), sn = *(const f32x4*)(ropes + ri);
                            const f32x4 lo = v0 * cs - v1 * sn, hi = v1 * cs + v0 * sn;
                            typedef unsigned u32x2 __attribute__((ext_vector_type(2)));
                            u32x2 a, c2; a.x = cvt_pk_bf16(lo[0], lo[1]); a.y = cvt_pk_bf16(lo[2], lo[3]); c2.x = cvt_pk_bf16(hi[0], hi[1]); c2.y = cvt_pk_bf16(hi[2], hi[3]);
                            *(u32x2*)(p + 4 * fq) = a; *(u32x2*)(p + 16 + 4 * fq) = c2; }
                        else *(u32x4*)(p + wc * 32 + 8 * fq) = pack8(v0, v1); } }
        } else {
            const int row0 = u.pm * BM + wr * 64 + fr, col0 = (u.pn - 48) * BM + wc * 32 + 8 * fq;
            f32x4 bv[2][2];
#pragma unroll
            for (int bj = 0; bj < 2; ++bj)
#pragma unroll
                for (int n = 0; n < 2; ++n) bv[bj][n] = *(const f32x4*)(bgate + col0 + bj * HALF + 4 * n);
#pragma unroll
            for (int ai = 0; ai < 2; ++ai)
#pragma unroll
                for (int m = 0; m < 4; ++m) { bf16_t* rowp = gates + (size_t)(row0 + ai * HALF + m * 16) * 8192 + col0;
#pragma unroll
                    for (int bj = 0; bj < 2; ++bj) { f32x4 v0 = acc[ai][bj][m][0] + bv[bj][0], v1 = acc[ai][bj][m][1] + bv[bj][1];
#pragma unroll
                        for (int i = 0; i < 4; ++i) { v0[i] = sigm(v0[i]); v1[i] = sigm(v1[i]); }
                        *(u32x4*)(rowp + bj * HALF) = pack8(v0, v1); } }
        }
    }
};

template <bool FIRST> struct EpiMerge {
    static constexpr bool PERM = true, AFTER_DRAIN = false;
    const bf16_t* G; int goff; const bf16_t* T; bf16_t* O;
    __device__ __forceinline__ void operator()(const f32x4 (&acc)[2][2][4][2], const Unit& u, int wr, int wc, int fr, int fq) const {
        const int row0 = u.pm * BM + wr * 64 + fr, col0 = u.pn * BM + wc * 32 + 8 * fq;
#pragma unroll
        for (int ai = 0; ai < 2; ++ai)
#pragma unroll
            for (int m = 0; m < 4; ++m) { const size_t row = (size_t)(row0 + ai * HALF + m * 16);
#pragma unroll
                for (int bj = 0; bj < 2; ++bj) { f32x4 g0, g1; unpack8(*(const u32x4*)(G + row * 8192 + goff + col0 + bj * HALF), g0, g1);
                    f32x4 v0 = g0 * acc[ai][bj][m][0], v1 = g1 * acc[ai][bj][m][1];
                    if (!FIRST) { f32x4 t0, t1; unpack8(*(const u32x4*)(T + row * 4096 + col0 + bj * HALF), t0, t1); v0 += t0; v1 += t1; }
                    *(u32x4*)(O + row * 4096 + col0 + bj * HALF) = pack8(v0, v1); } }
    }
};

template <class Epi, class Sched, bool ALIGN_EPI = false, bool SP2 = false>
__device__ __forceinline__ void gemm_phase(PG8_LAS unsigned char* lds, const Gemm g, const Sched& S, const Epi& E) {
    int tid_l = threadIdx.x; asm volatile("" : "+v"(tid_l)); const int tid = tid_l, wid = __builtin_amdgcn_readfirstlane(tid >> 6), lane = tid & 63, wr = wid >> 2, wc = wid & 3, fr = lane & 15, fq = lane >> 4;
    const int K = g.K, nt = K / BK;
    unsigned voffA[2], voffB[2];
#pragma unroll
    for (int i = 0; i < 2; ++i) { int R, C; stage_rc(tid * 16 + i * 8192, R, C); const int Rb = Epi::PERM ? ((R & ~31) + perm32(R & 31)) : R;
        voffA[i] = (unsigned)(R * K + C) * 2u; voffB[i] = (unsigned)(Rb * K + C) * 2u; }
    const size_t kstep = (size_t)(BK * 2);
    const size_t hstep = (size_t)HALF * K * 2;
    const size_t tstep = 2 * hstep;
    const unsigned ldsw = (unsigned)wid * 1024u;
    const int aoff = lds_byte(wr * 64 + fr, fq * 8), boff = lds_byte(wc * 32 + fr, fq * 8);
#define PG8_SA(b, h) (((b) * 2 + (h)) * HTB)
#define PG8_SB(b, h) ((4 + (b) * 2 + (h)) * HTB)
#define PG8_STAGE(bufoff, gbase, voff) do { _Pragma("unroll") for (int _i = 0; _i < 2; ++_i) \
        __builtin_amdgcn_global_load_lds((const unsigned*)((const char*)(gbase) + (voff)[_i]), (PG8_LAS unsigned*)(lds + (bufoff) + ldsw + _i * 8192), 16, 0, 0); } while (0)
#define PG8_LDA(dst, b, h) do { _Pragma("unroll") for (int m = 0; m < 4; ++m) _Pragma("unroll") for (int k = 0; k < 2; ++k) dst[m][k] = *(const PG8_LAS bf16x8*)(lds + PG8_SA(b, h) + aoff + m * 2048 + k * 1024); } while (0)
#define PG8_LDB(dst, b, h) do { _Pragma("unroll") for (int n = 0; n < 2; ++n) _Pragma("unroll") for (int k = 0; k < 2; ++k) dst[n][k] = *(const PG8_LAS bf16x8*)(lds + PG8_SB(b, h) + boff + n * 2048 + k * 1024); } while (0)
#define PG8_MMA(ai, bj, At, Bt) do { __builtin_amdgcn_s_setprio(1); _Pragma("unroll") for (int m = 0; m < 4; ++m) _Pragma("unroll") for (int n = 0; n < 2; ++n) _Pragma("unroll") for (int k = 0; k < 2; ++k) \
        acc[ai][bj][m][n] = __builtin_amdgcn_mfma_f32_16x16x32_bf16(Bt[n][k], At[m][k], acc[ai][bj][m][n], 0, 0, 0); __builtin_amdgcn_s_setprio(0); } while (0)
#define PG8_WAIT_V(n) asm volatile("s_waitcnt vmcnt(" #n ")" ::: "memory")
#define PG8_WAIT_L(n) asm volatile("s_waitcnt lgkmcnt(" #n ")" ::: "memory")
#define PG8_BAR __builtin_amdgcn_s_barrier()
#define PG8_SCHED __builtin_amdgcn_sched_barrier(0)
    Unit cur, nxt; int ui = 0;
    if (!S.next(0, cur)) return;
    f32x4 acc[2][2][4][2];
#pragma unroll
    for (int a = 0; a < 2; ++a)
#pragma unroll
        for (int b = 0; b < 2; ++b)
#pragma unroll
            for (int m = 0; m < 4; ++m)
#pragma unroll
                for (int n = 0; n < 2; ++n) acc[a][b][m][n] = (f32x4){0.f, 0.f, 0.f, 0.f};
    bf16x8 At[4][2], B0[2][2], B1[2][2];
    const char* cA = (const char*)g.A + (size_t)cur.pm * tstep; const char* cB = (const char*)g.Bt + (size_t)cur.pn * tstep;
    S.a_ready(cur);
    if constexpr (SP2) {
        PG8_STAGE(PG8_SB(0, 0), cB, voffB); PG8_STAGE(PG8_SB(0, 1), cB + hstep, voffB); PG8_STAGE(PG8_SA(0, 0), cA, voffA); PG8_STAGE(PG8_SA(0, 1), cA + hstep, voffA);
        if (wr == 1) PG8_BAR;
        PG8_WAIT_V(2); PG8_BAR;
        PG8_STAGE(PG8_SB(1, 0), cB + kstep, voffB); PG8_STAGE(PG8_SA(1, 0), cA + kstep, voffA); PG8_STAGE(PG8_SB(1, 1), cB + hstep + kstep, voffB);
        PG8_WAIT_V(6); PG8_BAR;
    } else {
        PG8_STAGE(PG8_SB(0, 0), cB, voffB); PG8_STAGE(PG8_SA(0, 0), cA, voffA); PG8_STAGE(PG8_SB(0, 1), cB + hstep, voffB); PG8_STAGE(PG8_SA(0, 1), cA + hstep, voffA);
        if (wr == 1) PG8_BAR;
        PG8_WAIT_V(4); PG8_BAR;
        PG8_STAGE(PG8_SB(1, 0), cB + kstep, voffB); PG8_STAGE(PG8_SA(1, 0), cA + kstep, voffA); PG8_STAGE(PG8_SB(1, 1), cB + hstep + kstep, voffB);
        PG8_WAIT_V(6); PG8_BAR;
    }
    for (;;) {
        const bool has_next = S.next(ui + 1, nxt);
        const char* nA = has_next ? (const char*)g.A + (size_t)nxt.pm * tstep : cA; const char* nB = has_next ? (const char*)g.Bt + (size_t)nxt.pn * tstep : cB;
        for (int t = 0; t < nt; t += 2) {
            const bool last = (t == nt - 2);
            const char* a1 = cA + (size_t)(t + 1) * kstep;
            const char* a2 = last ? nA : cA + (size_t)(t + 2) * kstep; const char* b2 = last ? nB : cB + (size_t)(t + 2) * kstep;
            const char* a3 = a2 + kstep; const char* b3 = b2 + kstep;
            if (last && has_next) S.a_ready(nxt);
            if constexpr (SP2) {
            PG8_LDB(B0, 0, 0); PG8_LDB(B1, 0, 1); PG8_SCHED; PG8_LDA(At, 0, 0); PG8_STAGE(PG8_SA(1, 1), a1 + hstep, voffA);
            PG8_WAIT_V(8); PG8_WAIT_L(0); PG8_BAR; PG8_MMA(0, 0, At, B0); PG8_MMA(0, 1, At, B1); PG8_BAR; PG8_SCHED;
            PG8_LDA(At, 0, 1); PG8_STAGE(PG8_SB(0, 0), b2, voffB); PG8_STAGE(PG8_SB(0, 1), b2 + hstep, voffB); PG8_STAGE(PG8_SA(0, 0), a2, voffA);
            PG8_WAIT_V(8); PG8_WAIT_L(0); PG8_BAR; PG8_MMA(1, 0, At, B0); PG8_MMA(1, 1, At, B1); PG8_BAR; PG8_SCHED;
            PG8_LDB(B0, 1, 0); PG8_LDB(B1, 1, 1); PG8_SCHED; PG8_LDA(At, 1, 0); PG8_STAGE(PG8_SA(0, 1), a2 + hstep, voffA);
            PG8_WAIT_V(8); PG8_WAIT_L(0); PG8_BAR; PG8_MMA(0, 0, At, B0); PG8_MMA(0, 1, At, B1); PG8_BAR; PG8_SCHED;
            PG8_LDA(At, 1, 1); PG8_STAGE(PG8_SB(1, 0), b3, voffB); PG8_STAGE(PG8_SB(1, 1), b3 + hstep, voffB); PG8_STAGE(PG8_SA(1, 0), a3, voffA);
            PG8_WAIT_V(8); PG8_WAIT_L(0); PG8_BAR; PG8_MMA(1, 0, At, B0); PG8_MMA(1, 1, At, B1); PG8_BAR; PG8_SCHED;
            } else {
            PG8_LDB(B0, 0, 0); PG8_SCHED; PG8_LDA(At, 0, 0); PG8_STAGE(PG8_SA(1, 1), a1 + hstep, voffA);
            PG8_WAIT_L(8); PG8_BAR; PG8_WAIT_L(0); PG8_MMA(0, 0, At, B0); PG8_BAR; PG8_SCHED;
            PG8_LDB(B1, 0, 1); PG8_STAGE(PG8_SB(0, 0), b2, voffB);
            PG8_BAR; PG8_WAIT_L(0); PG8_MMA(0, 1, At, B1); PG8_BAR;
            PG8_LDA(At, 0, 1); PG8_STAGE(PG8_SA(0, 0), a2, voffA);
            PG8_BAR; PG8_WAIT_L(0); PG8_MMA(1, 0, At, B0); PG8_BAR; PG8_SCHED;
            PG8_STAGE(PG8_SB(0, 1), b2 + hstep, voffB);
            PG8_WAIT_V(6); PG8_BAR; PG8_MMA(1, 1, At, B1); PG8_BAR;
            PG8_LDB(B0, 1, 0); PG8_SCHED; PG8_LDA(At, 1, 0); PG8_STAGE(PG8_SA(0, 1), a2 + hstep, voffA);
            PG8_WAIT_L(8); PG8_BAR; PG8_WAIT_L(0); PG8_MMA(0, 0, At, B0); PG8_BAR; PG8_SCHED;
            PG8_LDB(B1, 1, 1); PG8_STAGE(PG8_SB(1, 0), b3, voffB);
            PG8_BAR; PG8_WAIT_L(0); PG8_MMA(0, 1, At, B1); PG8_BAR;
            PG8_LDA(At, 1, 1); PG8_STAGE(PG8_SA(1, 0), a3, voffA);
            PG8_BAR; PG8_WAIT_L(0); PG8_MMA(1, 0, At, B0); PG8_BAR; PG8_SCHED;
            PG8_STAGE(PG8_SB(1, 1), b3 + hstep, voffB);
            PG8_WAIT_V(6); PG8_BAR; PG8_MMA(1, 1, At, B1); PG8_BAR;
            }
        }
        if constexpr (ALIGN_EPI) { if (wr == 0) PG8_BAR; }
        if constexpr (!Epi::AFTER_DRAIN) { E(acc, cur, wr, wc, fr, fq); S.done(cur); }
        if (!has_next) break;
#pragma unroll
        for (int a = 0; a < 2; ++a)
#pragma unroll
            for (int b = 0; b < 2; ++b)
#pragma unroll
                for (int m = 0; m < 4; ++m)
#pragma unroll
                    for (int n = 0; n < 2; ++n) acc[a][b][m][n] = (f32x4){0.f, 0.f, 0.f, 0.f};
        cur = nxt; cA = nA; cB = nB; ++ui;
        if constexpr (ALIGN_EPI) { if (wr == 1) PG8_BAR; }
    }
    PG8_WAIT_V(0);
    if constexpr (!ALIGN_EPI) { if (wr == 0) PG8_BAR; }
    PG8_BAR;
    if constexpr (Epi::AFTER_DRAIN) { E.fused(acc, cur, wr, wc, fr, fq, lds, wid, lane); S.done(cur); }
#undef PG8_SA
#undef PG8_SB
#undef PG8_STAGE
#undef PG8_LDA
#undef PG8_LDB
#undef PG8_MMA
#undef PG8_WAIT_V
#undef PG8_WAIT_L
#undef PG8_BAR
#undef PG8_SCHED
}
}
namespace att {
using bf16 = __hip_bfloat16;
typedef short bf16x8 __attribute__((ext_vector_type(8)));
typedef short s16x4 __attribute__((ext_vector_type(4)));
typedef float f32x16 __attribute__((ext_vector_type(16)));
typedef float f32x4 __attribute__((ext_vector_type(4)));
typedef unsigned u32x4 __attribute__((ext_vector_type(4)));
constexpr int D = 128;
constexpr float SCALE = 0.08838834764831845f;
constexpr float THR = 8.f;
constexpr int NW = 8, QBLK = 32, KVBLK = 64, QB = NW * QBLK;
constexpr int SHM_V = KVBLK * D * 2, SHM_K = KVBLK * D * 2;
constexpr int OFF_WS = 2 * SHM_V + 2 * SHM_K;
constexpr int OFF_BIAS = OFF_WS + NW * 64 * 4;
constexpr int LDS_BYTES = OFF_BIAS + 4096 * 4;
constexpr unsigned WINF = 0x7fffffffu;

#define KSWZ(row, colB) ((row) * 256 + ((colB) ^ (((row) & 7) << 4)))
#define SBAR() __builtin_amdgcn_sched_barrier(0)
__device__ __forceinline__ int v_st(int k, int c) { const int kk = (k & ~0xC) | ((k & 4) << 1) | ((k & 8) >> 1); return ((kk >> 3) * 4 + (c >> 5)) * 512 + ((kk & 7) * 32 + (c & 31)) * 2; }
__device__ __forceinline__ int v_rd_base(int lane) { return ((lane & 3) << 3) | (((lane >> 2) & 3) << 6) | (((lane >> 4) & 1) << 5) | (((lane >> 5) & 1) << 8); }
constexpr int v_rd_off(int d0, int ks, int half) { return d0 * 512 + ks * 4096 + half * 2048; }
__device__ __forceinline__ int crow(int r, int hi) { return (r & 3) + 8 * (r >> 2) + 4 * hi; }
typedef __bf16 bf16x2_t __attribute__((ext_vector_type(2)));
typedef float f32x2_t __attribute__((ext_vector_type(2)));
__device__ __forceinline__ unsigned cvtpk(float lo, float hi) { const f32x2_t v = {lo, hi}; const bf16x2_t b = __builtin_convertvector(v, bf16x2_t); return __builtin_bit_cast(unsigned, b); }
__device__ __forceinline__ bf16x8 load8(const bf16* p) { return *reinterpret_cast<const bf16x8*>(p); }
__device__ __forceinline__ void mask_tile(f32x16& p0, f32x16& p1, int dq, unsigned W) {
    const float NEG = -__builtin_inff();
#pragma unroll
    for (int r = 0; r < 16; ++r) {
        const int c = (r & 3) + 8 * (r >> 2);
        if ((unsigned)(dq - c) >= W) p0[r] = NEG;
        if ((unsigned)(dq - c - 32) >= W) p1[r] = NEG;
    }
}
__device__ __forceinline__ void partialSM(f32x16& p0, f32x16& p1, float& m_reg, float& mn, float& alpha) {
    float pmax = p0[0]; for (int r = 1; r < 16; ++r) pmax = fmaxf(pmax, p0[r]); for (int r = 0; r < 16; ++r) pmax = fmaxf(pmax, p1[r]);
    { auto rr = __builtin_amdgcn_permlane32_swap(__float_as_uint(pmax), __float_as_uint(pmax), false, false);
      pmax = fmaxf(__uint_as_float(rr[0]), __uint_as_float(rr[1])); }
    constexpr float C2 = 1.4426950408889634f * SCALE;
    if (__builtin_expect(__all((pmax - m_reg) * SCALE <= THR), 1)) { mn = m_reg; alpha = 1.f; }
    else { mn = fmaxf(m_reg, pmax); alpha = __builtin_amdgcn_exp2f((m_reg - mn) * C2); m_reg = mn; }
    const float mnL = -mn * C2;
    for (int r = 0; r < 16; ++r) p0[r] = fmaf(p0[r], C2, mnL); for (int r = 0; r < 16; ++r) p1[r] = fmaf(p1[r], C2, mnL);
    for (int r = 0; r < 16; ++r) p0[r] = __builtin_amdgcn_exp2f(p0[r]);
}
__device__ __forceinline__ void finishSM(f32x16& p0, f32x16& p1, float alpha, float& l_reg, bf16x8& pa0, bf16x8& pa1, bf16x8& pa2, bf16x8& pa3) {
    for (int r = 0; r < 16; ++r) p1[r] = __builtin_amdgcn_exp2f(p1[r]);
    float ps = 0; for (int r = 0; r < 16; ++r) ps += p0[r]; for (int r = 0; r < 16; ++r) ps += p1[r];
    { auto rr = __builtin_amdgcn_permlane32_swap(__float_as_uint(ps), __float_as_uint(ps), false, false);
      ps = __uint_as_float(rr[0]) + __uint_as_float(rr[1]); }
    l_reg = l_reg * alpha + ps;
#define PK4(P, B_, OUT) do { unsigned a0 = cvtpk(P[B_+0], P[B_+1]), a1 = cvtpk(P[B_+2], P[B_+3]);                          \
        unsigned b0 = cvtpk(P[B_+4], P[B_+5]), b1 = cvtpk(P[B_+6], P[B_+7]);                                             \
        auto r0 = __builtin_amdgcn_permlane32_swap(a0, b0, false, false); auto r1 = __builtin_amdgcn_permlane32_swap(a1, b1, false, false); \
        u32x4 w = {r0[0], r1[0], r0[1], r1[1]}; OUT = *reinterpret_cast<bf16x8*>(&w); } while (0)
    PK4(p0, 0, pa0); PK4(p0, 8, pa1); PK4(p1, 0, pa2); PK4(p1, 8, pa3);
#undef PK4
}
template <int KB>
__device__ __forceinline__ void qkt(f32x16& p0, f32x16& p1, const char* K_lds, int r32, int hi, const bf16x8* qr, const float* bt) {
    { const f32x4 a0 = *(const f32x4*)(bt), a1 = *(const f32x4*)(bt + 8), a2 = *(const f32x4*)(bt + 16), a3 = *(const f32x4*)(bt + 24);
      const f32x4 c0 = *(const f32x4*)(bt + 32), c1 = *(const f32x4*)(bt + 40), c2 = *(const f32x4*)(bt + 48), c3 = *(const f32x4*)(bt + 56);
      p0 = (f32x16){a0[0], a0[1], a0[2], a0[3], a1[0], a1[1], a1[2], a1[3], a2[0], a2[1], a2[2], a2[3], a3[0], a3[1], a3[2], a3[3]};
      p1 = (f32x16){c0[0], c0[1], c0[2], c0[3], c1[0], c1[1], c1[2], c1[3], c2[0], c2[1], c2[2], c2[3], c3[0], c3[1], c3[2], c3[3]}; }
    const char* kb[4];
#pragma unroll
    for (int dd = 0; dd < 4; ++dd) kb[dd] = K_lds + KB * SHM_K + KSWZ(r32, (dd * 16 + hi * 8) * 2);
#pragma unroll
    for (int d0 = 0; d0 < 8; ++d0) { const char* a = kb[d0 & 3] + (d0 >> 2) * 128;
        bf16x8 b0 = *reinterpret_cast<const bf16x8*>(a);
        bf16x8 b1 = *reinterpret_cast<const bf16x8*>(a + 32 * 256);
        p0 = __builtin_amdgcn_mfma_f32_32x32x16_bf16(b0, qr[d0], p0, 0, 0, 0);
        p1 = __builtin_amdgcn_mfma_f32_32x32x16_bf16(b1, qr[d0], p1, 0, 0, 0); }
}
template <int VB>
__device__ __forceinline__ void pv_tile(f32x16* o, int vb0, bf16x8 pa0, bf16x8 pa1, bf16x8 pa2, bf16x8 pa3) {
#define TRRD(dst, off) asm volatile("ds_read_b64_tr_b16 %0, %1 offset:%2" : "=&v"(dst) : "v"(vb0), "i"(off) : "memory")
#define PV_D0(d0) do { s16x4 l0, l1, l2, l3, h0, h1, h2, h3; constexpr int b_ = VB * SHM_V + v_rd_off(d0, 0, 0);   \
        TRRD(l0, b_); TRRD(h0, b_ + 2048); TRRD(l1, b_ + 4096); TRRD(h1, b_ + 6144); TRRD(l2, b_ + 8192); TRRD(h2, b_ + 10240); TRRD(l3, b_ + 12288); TRRD(h3, b_ + 14336); \
        asm volatile("s_waitcnt lgkmcnt(0)" ::: "memory"); SBAR();   \
        o[d0] = __builtin_amdgcn_mfma_f32_32x32x16_bf16(pa0, (bf16x8){l0[0], l0[1], l0[2], l0[3], h0[0], h0[1], h0[2], h0[3]}, o[d0], 0, 0, 0);   \
        o[d0] = __builtin_amdgcn_mfma_f32_32x32x16_bf16(pa1, (bf16x8){l1[0], l1[1], l1[2], l1[3], h1[0], h1[1], h1[2], h1[3]}, o[d0], 0, 0, 0);   \
        o[d0] = __builtin_amdgcn_mfma_f32_32x32x16_bf16(pa2, (bf16x8){l2[0], l2[1], l2[2], l2[3], h2[0], h2[1], h2[2], h2[3]}, o[d0], 0, 0, 0);   \
        o[d0] = __builtin_amdgcn_mfma_f32_32x32x16_bf16(pa3, (bf16x8){l3[0], l3[1], l3[2], l3[3], h3[0], h3[1], h3[2], h3[3]}, o[d0], 0, 0, 0); } while (0)
    PV_D0(0); PV_D0(1); PV_D0(2); PV_D0(3);
#undef PV_D0
#undef TRRD
}

struct BlockRef { const bf16* Q; const bf16* K; const bf16* V; bf16* O; const float* kb; int P0, opitch, CH; };
struct Seam { bf16x8 qr[8]; bf16x8 st_v0, st_v1, st_k0, st_k1; };
#define ROW(p, k0, rr) ((p) + (size_t)((k0) + (rr)) * D + sc)
#define VMW() asm volatile("s_waitcnt vmcnt(0)" ::: "memory")
#define VMWN(n) asm volatile("s_waitcnt vmcnt(%0)" :: "i"(n) : "memory")
#define SLOAD_H(Kp, Vp, k0) do { S.st_v0 = load8(ROW(Vp, k0, sr)); S.st_v1 = load8(ROW(Vp, k0, 32 + sr));              \
                         S.st_k0 = load8(ROW(Kp, k0, sr)); S.st_k1 = load8(ROW(Kp, k0, 32 + sr)); } while (0)
#define SWRITE_HK(bf) do { *(bf16x8*)(K_lds + (bf) * SHM_K + kws) = S.st_k0; *(bf16x8*)(K_lds + (bf) * SHM_K + kws + 32 * 256) = S.st_k1; } while (0)
#define SWRITE_HV(bf) do { *(bf16x8*)(V_lds + (bf) * SHM_V + vst0) = S.st_v0; *(bf16x8*)(V_lds + (bf) * SHM_V + vst1) = S.st_v1; } while (0)
#define SWRITE_H(bf) do { SWRITE_HV(bf); SWRITE_HK(bf); } while (0)
__device__ __forceinline__ void block_prime(const BlockRef& cur, char* lds, Seam& S) {
    int tid_l = threadIdx.x; asm volatile("" : "+v"(tid_l)); const int tid = tid_l, wid = __builtin_amdgcn_readfirstlane(tid >> 6), lane = tid & 63, r32 = lane & 31, hi = lane >> 5;
    const int sr = tid >> 4, sc = (tid & 15) * 8, kws = KSWZ(sr, sc * 2); char* K_lds = lds + 2 * SHM_V;
    for (int d0 = 0; d0 < 8; ++d0) S.qr[d0] = load8(cur.Q + (size_t)(wid * QBLK + r32) * D + d0 * 16 + hi * 8);
    SLOAD_H(cur.K, cur.V, 0); VMW(); SWRITE_HK(0);
    __syncthreads();
}
__device__ __forceinline__ void block_run(const BlockRef& cur, const BlockRef& nxt, char* lds, Seam& S) {
    int tid_l = threadIdx.x; asm volatile("" : "+v"(tid_l)); const int tid = tid_l, wid = __builtin_amdgcn_readfirstlane(tid >> 6), lane = tid & 63, r32 = lane & 31, hi = lane >> 5;
    const int NT = cur.P0 / KVBLK + QB / KVBLK;
    const int qlo = cur.P0 + wid * QBLK, qlo_m = qlo | cur.CH, qm = ((qlo + r32) | cur.CH) - 4 * hi;
    char* V_lds = lds; char* K_lds = lds + 2 * SHM_V;
    float* ws = (float*)(lds + OFF_WS) + wid * 64; float* li_l = ws, * al_l = ws + 32;
    float* bl = (float*)(lds + OFF_BIAS);
    { const int nk = cur.P0 + QB;
      for (int i = tid * 4; i < nk; i += 2048) { f32x4 v = {0.f, 0.f, 0.f, 0.f}; if (cur.kb) v = *(const f32x4*)(cur.kb + i); *(f32x4*)(bl + i) = v; }
      __syncthreads(); }
    const float* blh = bl + hi * 4;
    float m_reg = -1e30f, l_reg = 0; f32x16 o[4] = {};
    const int sr = tid >> 4, sc = (tid & 15) * 8, vst0 = v_st(sr, sc), vst1 = v_st(32 + sr, sc), kws = KSWZ(sr, sc * 2);
    const int vb0 = (int)(uintptr_t)V_lds + v_rd_base(lane);
    const bf16* Kh = cur.K; const bf16* Vh = cur.V;
#define RESC(a) do { if (__any((a) < 1.f)) { if (hi == 0) al_l[r32] = (a); asm volatile("s_waitcnt lgkmcnt(0)" ::: "memory");              \
                     for (int d_ = 0; d_ < 4; ++d_) for (int r = 0; r < 16; ++r) o[d_][r] *= al_l[crow(r, hi)]; } } while (0)
#define KBASE(t) ((t) * KVBLK)
#define MASKT(P0_, P1_, t) do { const int kb_ = KBASE(t); if (kb_ + KVBLK - 1 > qlo_m) mask_tile(P0_, P1_, qm - kb_, WINF); } while (0)
#define SEAM_K0() do { VMWN(8); SWRITE_HK(0); SBAR(); } while (0)
    f32x16 pA0, pA1, pB0, pB1; float mnA, mnB, alA, alB; bf16x8 pa0, pa1, pa2, pa3;
    SWRITE_HV(0); SBAR();
    if (NT > 1) SLOAD_H(Kh, Vh, KBASE(1));
    SBAR(); qkt<0>(pA0, pA1, K_lds, r32, hi, S.qr, blh + KBASE(0));
    MASKT(pA0, pA1, 0); partialSM(pA0, pA1, m_reg, mnA, alA);
    if (NT > 1) { VMW(); SWRITE_H(1); }
    __syncthreads();
#define HALF_STEP(PX0, PX1, mnX, alX, PY0, PY1, alY, t, KB, VB, SB) do {                                                      \
        SBAR(); qkt<KB>(PX0, PX1, K_lds, r32, hi, S.qr, blh + KBASE(t));                                                      \
        finishSM(PY0, PY1, alY, l_reg, pa0, pa1, pa2, pa3); SBAR();                                                           \
        if ((t) + 1 < NT) { SLOAD_H(Kh, Vh, KBASE((t) + 1)); SBAR(); }                                                        \
        pv_tile<VB>(o, vb0, pa0, pa1, pa2, pa3); MASKT(PX0, PX1, (t)); partialSM(PX0, PX1, m_reg, mnX, alX);                  \
        __syncthreads();                                                                                                      \
        if ((t) + 1 < NT) { VMW(); SWRITE_H(SB); }                                                                            \
        RESC(alX); __syncthreads(); } while (0)
    for (int t = 1; t + 1 < NT; t += 2) {
        HALF_STEP(pB0, pB1, mnB, alB, pA0, pA1, alA, t, 1, 0, 0);
        HALF_STEP(pA0, pA1, mnA, alA, pB0, pB1, alB, t + 1, 0, 1, 1);
    }
    const bool even = (NT & 1) == 0;
    if (even) { SBAR(); qkt<1>(pB0, pB1, K_lds, r32, hi, S.qr, blh + KBASE(NT - 1)); SBAR(); }
    SLOAD_H(nxt.K, nxt.V, 0); SBAR();
#pragma unroll
    for (int d0 = 0; d0 < 8; ++d0) S.qr[d0] = load8(nxt.Q + (size_t)(wid * QBLK + r32) * D + d0 * 16 + hi * 8);
    SBAR();
    finishSM(pA0, pA1, alA, l_reg, pa0, pa1, pa2, pa3); SBAR();
    pv_tile<0>(o, vb0, pa0, pa1, pa2, pa3);
    if (even) { MASKT(pB0, pB1, NT - 1); partialSM(pB0, pB1, m_reg, mnB, alB); __syncthreads(); RESC(alB);
        finishSM(pB0, pB1, alB, l_reg, pa0, pa1, pa2, pa3); SBAR(); pv_tile<1>(o, vb0, pa0, pa1, pa2, pa3); }
    SBAR(); SEAM_K0();
    if (hi == 0) li_l[r32] = l_reg; asm volatile("s_waitcnt lgkmcnt(0)" ::: "memory");
    float rli[16];
#pragma unroll
    for (int r = 0; r < 16; ++r) rli[r] = __builtin_amdgcn_rcpf(li_l[crow(r, hi)]);
    bf16* Ow = cur.O + (size_t)(wid * QBLK) * cur.opitch;
#pragma unroll
    for (int r = 0; r < 16; ++r) { const int orow = crow(r, hi);
#pragma unroll
        for (int d0 = 0; d0 < 4; ++d0) { const float v = o[d0][r] * rli[r];
            const float vn = __shfl_xor(v, 1);
            if ((r32 & 1) == 0) *(unsigned*)(Ow + (size_t)orow * cur.opitch + d0 * 32 + r32) = cvtpk(v, vn); } }
    __syncthreads();
#undef RESC
#undef KBASE
#undef MASKT
#undef SEAM_K0
#undef HALF_STEP
}
#undef ROW
#undef VMW
#undef VMWN
#undef SLOAD_H
#undef SWRITE_HK
#undef SWRITE_HV
#undef SWRITE_H
#undef KSWZ
#undef SBAR
}
#define GAS __attribute__((address_space(1)))
#define LAS __attribute__((address_space(3)))
typedef unsigned short bf16;
typedef unsigned v4u __attribute__((ext_vector_type(4)));
typedef float f32x4 __attribute__((ext_vector_type(4)));
typedef short bf16x8 __attribute__((ext_vector_type(8)));
typedef GAS unsigned gu32;
typedef GAS unsigned long long gu64;
#define RLX_AGENT __ATOMIC_RELAXED, __HIP_MEMORY_SCOPE_AGENT
#define LDS_WAIT() asm volatile("s_waitcnt lgkmcnt(0)" ::: "memory")
#define VM_WAIT() asm volatile("s_waitcnt vmcnt(0)" ::: "memory")
__device__ __forceinline__ unsigned long long rt() { return __builtin_amdgcn_s_memrealtime(); }
__device__ __forceinline__ unsigned f2bf(float f) { unsigned u = __builtin_bit_cast(unsigned, f); return (u + 0x7fffu + ((u >> 16) & 1u)) >> 16; }
__device__ __forceinline__ unsigned pk2(float lo, float hi) { return f2bf(lo) | (f2bf(hi) << 16); }
#define XB_TMO      128
#define XB_XCNT(j)  (256  + 64 * (j))
#define XB_XSUB(j)  (1280 + 64 * (j))
#define XB_XGEN(j)  (2304 + 64 * (j))
#define XB_TOP      3328
#define XB_TOPGEN   3392
#define XCD_BAR_WORDS 3456
#define XB_SPIN_CAP (1u << 18)

__device__ __forceinline__ unsigned xb_ld(unsigned* p)              { return __hip_atomic_load(p, __ATOMIC_RELAXED, __HIP_MEMORY_SCOPE_AGENT); }
__device__ __forceinline__ unsigned xb_add(unsigned* p, unsigned v) { return __hip_atomic_fetch_add(p, v, __ATOMIC_RELAXED, __HIP_MEMORY_SCOPE_AGENT); }
__device__ __forceinline__ unsigned xb_xcc_id() { return (unsigned)__builtin_amdgcn_s_getreg((3 << 11) | 20) & 0xFu; }
#define XB_SPIN(cond, bar) do { unsigned _sp = 0; while (cond) { __builtin_amdgcn_s_sleep(1); \
    if ((++_sp & 255u) == 0u) { if (xb_ld(&(bar)[XB_TMO])) break; if (_sp > XB_SPIN_CAP) { atomicAdd(&(bar)[XB_TMO], 1u); break; } } } } while (0)

struct XcdBarrier {
    unsigned* bar; unsigned x;
    volatile LAS unsigned* st;
};

__device__ __forceinline__ XcdBarrier xcd_barrier_post(unsigned* bar, volatile LAS unsigned* st) {
    XcdBarrier b; b.bar = bar; b.x = xb_xcc_id(); b.st = st;
    if (threadIdx.x == 0) (void)xb_add(&bar[XB_XCNT(b.x)], 1u);
    return b;
}
__device__ __forceinline__ void xcd_barrier_complete(unsigned* bar, unsigned x, unsigned& nloc, unsigned& nx) {
    const unsigned G = gridDim.x * gridDim.y * gridDim.z;
    unsigned sum, cnt, mine, sp = 0u;
    for (;;) {
        sum = 0u; cnt = 0u; mine = 0u;
#pragma unroll
        for (unsigned j = 0; j < 16; ++j) { const unsigned c = xb_ld(&bar[XB_XCNT(j)]); sum += c; cnt += (c > 0u) ? 1u : 0u; mine = (j == x) ? c : mine; }
        if (sum == G) break;
        __builtin_amdgcn_s_sleep(1);
        if ((++sp & 255u) == 0u) { if (xb_ld(&bar[XB_TMO])) break; if (sp > XB_SPIN_CAP) { atomicAdd(&bar[XB_TMO], 1u); break; } }
    }
    nloc = mine > 0u ? mine : 1u; nx = cnt > 0u ? cnt : 1u;
}

__device__ __forceinline__ void xcd_barrier(const XcdBarrier& b) {
    asm volatile("s_waitcnt vmcnt(0)" ::: "memory");
    __syncthreads();
    if (threadIdx.x == 0) {
        unsigned* bar = b.bar;
        __builtin_amdgcn_s_waitcnt(0);
        unsigned nloc = b.st[0], nx = b.st[1];
        if (nloc == 0u) { xcd_barrier_complete(bar, b.x, nloc, nx); b.st[0] = nloc; b.st[1] = nx; }
        const unsigned old = xb_add(&bar[XB_XSUB(b.x)], 1u);
        const unsigned gen = old / nloc;
        if (old + 1u == (gen + 1u) * nloc) {
            __builtin_amdgcn_fence(__ATOMIC_RELEASE, "agent");
            asm volatile("s_waitcnt vmcnt(0)" ::: "memory");
            const unsigned og = xb_add(&bar[XB_TOP], 1u);
            const unsigned tg = og / nx;
            if (og + 1u == (tg + 1u) * nx) xb_add(&bar[XB_TOPGEN], 1u);
            else XB_SPIN(xb_ld(&bar[XB_TOPGEN]) == tg, bar);
            __builtin_amdgcn_fence(__ATOMIC_ACQUIRE, "agent");
            xb_add(&bar[XB_XGEN(b.x)], 1u);
            asm volatile("s_waitcnt vmcnt(0)" ::: "memory");
        } else {
            XB_SPIN(xb_ld(&bar[XB_XGEN(b.x)]) == gen, bar);
            __builtin_amdgcn_fence(__ATOMIC_ACQUIRE, "agent");
            asm volatile("s_waitcnt vmcnt(0)" ::: "memory");
        }
    }
    __syncthreads();
}
__device__ __forceinline__ float wave_sum(float v) {
#pragma unroll
    for (int o = 1; o < 64; o <<= 1) v += __shfl_xor(v, o);
    return v;
}
constexpr int NWAVES = 8;
#ifndef ST_FFN1
#define ST_FFN1 1
#endif
#ifndef ST_MIX
#define ST_MIX 1
#endif
#ifndef ST_FFN2
#define ST_FFN2 1
#endif
#ifndef ST_ATT
#define ST_ATT 1
#endif
#ifndef ST_MA
#define ST_MA 1
#endif
#ifndef ST_P5
#define ST_P5 1
#endif
#ifndef ST_FF
#define ST_FF 1
#endif
constexpr int BATCH = 4, SEQ = 4096, DM = 4096, M = BATCH * SEQ, DFF = 11008, NFF2 = 2 * DFF;
constexpr int INCOLS = 20496, NPROJ = 20480;
constexpr int NADA = 9 * DM, NFADA = 2 * DM, NMODC = NADA + NFADA;
constexpr int KCH = 32, KCHR = DM / KCH;
constexpr float RMS_EPS = 1e-6f;
constexpr size_t MiB = 1u << 20;
constexpr size_t WS_CTL = 0, CTL_ZERO_BYTES = 1 * MiB;
constexpr size_t WS_MODV = 1 * MiB;
constexpr size_t WS_ROPEC = 2 * MiB, WS_ROPES = 3 * MiB;
constexpr size_t WS_KBIAS = 4 * MiB;
constexpr size_t WS_LOGF = 5 * MiB;
constexpr size_t WS_WFF = 6 * MiB;
constexpr size_t WS_PART = 8 * MiB;
constexpr size_t WS_W1IN = 30 * MiB, WS_W1OUT = 202 * MiB, WS_W2IN = 288 * MiB, WS_W2OUT = 460 * MiB, WS_WIN = 546 * MiB, WS_WOFOX = 706 * MiB, WS_WODIFF = 722 * MiB, WS_WOUT = 738 * MiB;
constexpr size_t WS_HB = 770 * MiB;
constexpr size_t WS_BIG = 898 * MiB;
constexpr size_t WS_QKV = WS_BIG, WS_GATES = WS_BIG + 384 * MiB;
constexpr size_t WS_YA = 1538 * MiB;
constexpr size_t WS_ODIFF = 1602 * MiB;
constexpr size_t WS_YB = 1730 * MiB;
constexpr size_t WS_TMP = 1794 * MiB;
constexpr size_t WS_END = 1922 * MiB;
static_assert(WS_PART + (size_t)KCH * 4 * NMODC * 4 <= WS_W1IN && WS_W1IN + (size_t)NFF2 * DM * 2 <= WS_W1OUT && WS_W1OUT + (size_t)DM * DFF * 2 <= WS_W2IN && WS_WIN + (size_t)NPROJ * DM * 2 <= WS_WOFOX &&
              WS_BIG + (size_t)M * DFF * 2 <= WS_YA && WS_GATES + (size_t)M * 8192 * 2 <= WS_YA, "d_ws map");
constexpr int CW_BAR = 4096;
constexpr int RING_OFF = 0, RING_BYTES = 131072;
constexpr int LDSCTL_OFF = RING_BYTES, MISC_OFF = LDSCTL_OFF + 320;
constexpr int LDS_BYTES = 147456;
static_assert(MISC_OFF + 128 <= LDS_BYTES && att::LDS_BYTES <= RING_BYTES, "LDS map");

template <class Map>
__device__ __forceinline__ void p0_transpose_item(const float* W, int K, int N, const Map& mp, LAS float* scr, int item, int lane) {
    const int nblk = (N + 31) / 32, kb = item / nblk, nb = item % nblk, k0 = 64 * kb, n0 = 32 * nb;
    const bool okc = n0 + (lane & 31) < N;
#pragma unroll 8
    for (int i = 0; i < 32; ++i) { const int kk = 2 * i + (lane >> 5); scr[kk * 33 + (lane & 31)] = okc ? W[(size_t)(k0 + kk) * N + n0 + (lane & 31)] : 0.f; }
    LDS_WAIT(); asm volatile("" ::: "memory");
    const int c = lane & 7;
#pragma unroll
    for (int j = 0; j < 4; ++j) { const int n = (lane >> 3) + 8 * j; const LAS float* s = scr + (8 * c) * 33 + n;
        v4u o; o.x = pk2(s[0 * 33], s[1 * 33]); o.y = pk2(s[2 * 33], s[3 * 33]); o.z = pk2(s[4 * 33], s[5 * 33]); o.w = pk2(s[6 * 33], s[7 * 33]);
        bf16* dst = (n0 + n < N) ? mp(n0 + n) : nullptr;
        if (dst) *(GAS v4u*)(dst + k0 + 8 * c) = o; }
    LDS_WAIT(); asm volatile("" ::: "memory");
}
struct MapId { bf16* WT; int K; __device__ __forceinline__ bf16* operator()(int n) const { return WT + (size_t)n * K; } };
struct MapGlu { bf16* WT; __device__ __forceinline__ bf16* operator()(int n) const { const int up = n >= DFF, j = n - up * DFF; return WT + (size_t)((j >> 7) * 256 + up * 128 + (j & 127)) * DM; } };
struct MapWin { bf16* WT; bf16* WFF; __device__ __forceinline__ bf16* operator()(int n) const {
    if (n >= 6144 && n < 6160) return WFF + (size_t)(n - 6144) * DM;
    int r = n < 6144 ? n : n - 16;
    if (r >= 6144 && r < 10240) { const int a = r & 127; if (a < 32) { const int a2 = a & 15; r = (r & ~127) + 8 * (a2 >> 2) + 4 * (a >> 4) + (a2 & 3); } }
    return WT + (size_t)r * DM; } };

__device__ __forceinline__ void gemv_task(const float* W, int N, const float* cvec, float* part, int ncol_off, int task, LAS float* scs, int lane) {
    const int nstrips = N / 256, kc = task / nstrips, strip = task % nstrips, n = strip * 256 + lane * 4, k0 = kc * KCHR;
#pragma unroll
    for (int j = 0; j < KCHR / 64; ++j) { const int kk = lane + 64 * j;
#pragma unroll
        for (int b = 0; b < 4; ++b) { const float x = cvec[b * DM + k0 + kk]; scs[kk * 4 + b] = x / (1.f + __expf(-x)); } }
    LDS_WAIT(); asm volatile("" ::: "memory");
    f32x4 a0 = {0.f, 0.f, 0.f, 0.f}, a1 = a0, a2 = a0, a3 = a0;
    const float* wp = W + (size_t)k0 * N + n;
#pragma unroll 8
    for (int kk = 0; kk < KCHR; ++kk) { const f32x4 w = *(const GAS f32x4*)(wp + (size_t)kk * N); const f32x4 s4 = *(const LAS f32x4*)(scs + kk * 4);
        a0 += s4[0] * w; a1 += s4[1] * w; a2 += s4[2] * w; a3 += s4[3] * w; }
    float* pp = part + (size_t)(kc * 4) * NMODC + ncol_off + n;
    *(GAS f32x4*)(pp) = a0; *(GAS f32x4*)(pp + NMODC) = a1; *(GAS f32x4*)(pp + 2 * NMODC) = a2; *(GAS f32x4*)(pp + 3 * NMODC) = a3;
    LDS_WAIT(); asm volatile("" ::: "memory");
}
__constant__ float c_inv_freq[16] = {1.000000000e+00f, 4.403665960e-01f, 1.939227432e-01f, 8.539710194e-02f, 3.760603070e-02f, 1.656043902e-02f, 7.292664610e-03f, 3.211445874e-03f,
                                     1.414213562e-03f, 6.227723788e-04f, 2.742481884e-04f, 1.207697351e-04f, 5.318296098e-05f, 2.341999971e-05f, 1.031338616e-05f, 4.541670478e-06f};
__device__ __forceinline__ void sincos_f64(float angf, float& c, float& s) {
    const double a = (double)angf; const double kq = __builtin_rint(a * 0.63661977236758134308);
    const double r = (a - kq * 1.57079632679489655800e+00) - kq * 6.12323399573676603587e-17; const double r2 = r * r;
    const double sp = r * (1.0 + r2 * (-1.66666666666666324348e-01 + r2 * (8.33333333332248946124e-03 + r2 * (-1.98412698298579493134e-04 + r2 * (2.75573137070700676789e-06 + r2 * (-2.50507602534068634195e-08 + r2 * 1.58969099521155010221e-10))))));
    const double cp = 1.0 + r2 * (-0.5 + r2 * (4.16666666666666019037e-02 + r2 * (-1.38888888888741095749e-03 + r2 * (2.48015872894767294178e-05 + r2 * (-2.75573143513906633035e-07 + r2 * (2.08757232129817482790e-09 + r2 * -1.13596475577881948265e-11))))));
    const int q = (int)((long long)kq & 3);
    const double sv = (q & 1) ? cp : sp, cv = (q & 1) ? sp : cp;
    s = (float)((q & 2) ? -sv : sv); c = (float)(((q + 1) & 2) ? -cv : cv);
}

template <bool OUT_F32>
__device__ __forceinline__ void norm_phase(const float* X, void* OUT, const float* Avec, const float* SHvec, LAS unsigned char* lds, int vcu, int G, int tid, int wave, int lane, bool poison) {
    LAS f32x4* LA = (LAS f32x4*)lds; LAS f32x4* LS = (LAS f32x4*)(lds + 16384);
    for (int panel = vcu; panel < M / 64; panel += G) { const int b = panel >> 6;
        for (int i = tid; i < 1024; i += NWAVES * 64) { LA[i] = *(const GAS f32x4*)(Avec + b * DM + 4 * i); LS[i] = *(const GAS f32x4*)(SHvec + b * DM + 4 * i); }
        __syncthreads();
        for (int rr = 0; rr < 8; ++rr) { const int row = panel * 64 + wave * 8 + rr;
            const GAS f32x4* xr = (const GAS f32x4*)(X + (size_t)row * DM) + lane;
            f32x4 v[16]; float ss = 0.f;
#pragma unroll
            for (int j = 0; j < 16; ++j) { v[j] = xr[64 * j]; ss += (v[j].x * v[j].x + v[j].y * v[j].y) + (v[j].z * v[j].z + v[j].w * v[j].w); }
            float r = 1.f / sqrtf(wave_sum(ss) * (1.f / DM) + RMS_EPS); if (poison) r = __builtin_nanf("");
#pragma unroll
            for (int j = 0; j < 16; ++j) { const f32x4 y = v[j] * r * LA[lane + 64 * j] + LS[lane + 64 * j];
                if (OUT_F32) ((GAS f32x4*)((float*)OUT + (size_t)row * DM) + lane)[64 * j] = y;
                else ((GAS unsigned long long*)((bf16*)OUT + (size_t)row * DM) + lane)[64 * j] = (unsigned long long)pk2(y.x, y.y) | ((unsigned long long)pk2(y.z, y.w) << 32); } }
        __syncthreads(); }
}

__device__ __forceinline__ void ff_phase(const bf16* H, const bf16* Wff, const float* bfg, float* logf, int vcu, int G, int wave, int lane) {
    const int fr = lane & 15, fq = lane >> 4;
    for (int t = wave * G + vcu; t < M / 16; t += NWAVES * G) { const int row0 = t * 16; f32x4 acc = {0.f, 0.f, 0.f, 0.f};
        const bf16* ap = H + (size_t)(row0 + fr) * DM + 8 * fq; const bf16* wp = Wff + (size_t)fr * DM + 8 * fq;
#pragma unroll 8
        for (int ks = 0; ks < DM / 32; ++ks) { const bf16x8 a = *(const GAS bf16x8*)(ap + 32 * ks), w = *(const GAS bf16x8*)(wp + 32 * ks); acc = __builtin_amdgcn_mfma_f32_16x16x32_bf16(w, a, acc, 0, 0, 0); }
        const int b = row0 >> 12, s = (row0 & 4095) + fr;
#pragma unroll
        for (int j = 0; j < 4; ++j) { const int h = 4 * fq + j; const float z = acc[j] + bfg[h]; const float ls = fminf(z, 0.f) - log1pf(__expf(-fabsf(z))); logf[(size_t)(b * 16 + h) * SEQ + s] = ls; } }
}
__device__ __forceinline__ void cumsum_phase(const float* logf, float* kbias, LAS unsigned char* lds, int vcu, int G, int tid, int wave, int lane) {
    LAS float* wt = (LAS float*)lds;
    for (int bh = vcu; bh < 64; bh += G) {
        const f32x4 x0 = *(const GAS f32x4*)(logf + (size_t)bh * SEQ + tid * 8), x1 = *(const GAS f32x4*)(logf + (size_t)bh * SEQ + tid * 8 + 4);
        float p[8]; p[0] = x0.x; p[1] = p[0] + x0.y; p[2] = p[1] + x0.z; p[3] = p[2] + x0.w; p[4] = p[3] + x1.x; p[5] = p[4] + x1.y; p[6] = p[5] + x1.z; p[7] = p[6] + x1.w;
        float sc = p[7];
#pragma unroll
        for (int o = 1; o < 64; o <<= 1) { const float t = __shfl_up(sc, o); if (lane >= o) sc += t; }
        if (lane == 63) wt[wave] = sc;
        __syncthreads();
        float base = sc - p[7];
        for (int w = 0; w < wave; ++w) base += wt[w];
        const float k = -11.313708498984761f;
        f32x4 o0, o1; o0.x = (base + p[0]) * k; o0.y = (base + p[1]) * k; o0.z = (base + p[2]) * k; o0.w = (base + p[3]) * k; o1.x = (base + p[4]) * k; o1.y = (base + p[5]) * k; o1.z = (base + p[6]) * k; o1.w = (base + p[7]) * k;
        *(GAS f32x4*)(kbias + (size_t)bh * SEQ + tid * 8) = o0; *(GAS f32x4*)(kbias + (size_t)bh * SEQ + tid * 8 + 4) = o1;
        __syncthreads(); }
}
__device__ __forceinline__ void diffcomb_phase(const bf16* OD, bf16* YB, const float* lamp, const float* subln, int vcu, int G, int wave, int lane) {
    float s1 = lamp[lane] * lamp[128 + lane] + lamp[64 + lane] * lamp[192 + lane], s2 = lamp[256 + lane] * lamp[384 + lane] + lamp[320 + lane] * lamp[448 + lane];
    s1 = wave_sum(s1); s2 = wave_sum(s2);
    const float lam = __expf(s1) - __expf(s2) + 0.2f;
    const f32x4 g = *(const GAS f32x4*)(subln + 4 * lane) * 0.8f;
    const int gw = vcu * NWAVES + wave, NGW = G * NWAVES;
    for (int m = gw; m < M; m += NGW) { const bf16* orow = OD + (size_t)m * 4096; bf16* yrow = YB + (size_t)m * 2048;
#pragma unroll 4
        for (int h = 0; h < 8; ++h) { const unsigned long long a = *(const GAS unsigned long long*)(orow + h * 512 + 4 * lane), c = *(const GAS unsigned long long*)(orow + h * 512 + 256 + 4 * lane);
            f32x4 y;
            y.x = __builtin_bit_cast(float, (unsigned)(a << 16)) - lam * __builtin_bit_cast(float, (unsigned)(c << 16));
            y.y = __builtin_bit_cast(float, (unsigned)a & 0xffff0000u) - lam * __builtin_bit_cast(float, (unsigned)c & 0xffff0000u);
            y.z = __builtin_bit_cast(float, (unsigned)(a >> 32) << 16) - lam * __builtin_bit_cast(float, (unsigned)(c >> 32) << 16);
            y.w = __builtin_bit_cast(float, (unsigned)(a >> 32) & 0xffff0000u) - lam * __builtin_bit_cast(float, (unsigned)(c >> 32) & 0xffff0000u);
            const float r = 1.f / sqrtf(wave_sum((y.x * y.x + y.y * y.y) + (y.z * y.z + y.w * y.w)) * (1.f / 256.f) + RMS_EPS);
            y = y * r * g;
            *(GAS unsigned long long*)(yrow + h * 256 + 4 * lane) = (unsigned long long)pk2(y.x, y.y) | ((unsigned long long)pk2(y.z, y.w) << 32); } }
}

__device__ __forceinline__ att::BlockRef att_ref(unsigned char* ws, int j, int G, int cc) {
    const int Lp = (j >> 1) * G + cc, grp = Lp >> 3, xx = Lp & 7, qb = (j & 1) ? 15 - xx : xx;
    att::BlockRef r;
    const att::bf16* Q6 = (const att::bf16*)(ws + WS_QKV); const size_t TS = (size_t)M * 2048, HS = (size_t)SEQ * 128;
    if (grp < 64) { const int b = grp >> 4, h = grp & 15;
        r.Q = Q6 + (size_t)grp * HS + (size_t)qb * 256 * 128; r.K = Q6 + TS + (size_t)grp * HS; r.V = Q6 + 2 * TS + (size_t)grp * HS;
        r.O = (att::bf16*)(ws + WS_YA) + ((size_t)b * SEQ + qb * 256) * 2048 + h * 128; r.opitch = 2048; r.kb = (const float*)(ws + WS_KBIAS) + (size_t)grp * SEQ; r.CH = 0; }
    else { const int vh = grp - 64, b = vh >> 5, rr = vh & 31, h = rr >> 2, n = (rr >> 1) & 1, half = rr & 1;
        r.Q = Q6 + 3 * TS + (size_t)(b * 16 + h * 2 + n) * HS + (size_t)qb * 256 * 128; r.K = Q6 + 4 * TS + (size_t)(b * 16 + h * 2 + n) * HS; r.V = Q6 + 5 * TS + (size_t)(b * 16 + h * 2 + half) * HS;
        r.O = (att::bf16*)(ws + WS_ODIFF) + ((size_t)b * SEQ + qb * 256) * 4096 + h * 512 + n * 256 + half * 128; r.opitch = 4096; r.kb = nullptr; r.CH = 63; }
    r.P0 = qb * 256; return r;
}
#define PH_BEGIN size_t ws_z = 0; asm volatile("" : "+s"(ws_z)); unsigned char* ws = args.ws + ws_z; int tid = threadIdx.x; asm volatile("" : "+v"(tid)); const int lane = tid & 63, wave = __builtin_amdgcn_readfirstlane(tid >> 6); (void)lane; (void)wave; (void)ws;
#define P_F32(off) ((float*)(ws + (off)))
#define P_BF(off) ((bf16*)(ws + (off)))
#define MODV P_F32(WS_MODV)
#define ROPEC P_F32(WS_ROPEC)
#define ROPES P_F32(WS_ROPES)
#define KBIAS P_F32(WS_KBIAS)
#define LOGF P_F32(WS_LOGF)
#define PART P_F32(WS_PART)
#define WFF P_BF(WS_WFF)
#define W1IN P_BF(WS_W1IN)
#define W1OUT P_BF(WS_W1OUT)
#define W2IN P_BF(WS_W2IN)
#define W2OUT P_BF(WS_W2OUT)
#define WIN P_BF(WS_WIN)
#define WOFOX P_BF(WS_WOFOX)
#define WODIFF P_BF(WS_WODIFF)
#define WOUT P_BF(WS_WOUT)
#define HB P_BF(WS_HB)
#define ACT P_BF(WS_BIG)
#define QKV P_BF(WS_QKV)
#define GATES P_BF(WS_GATES)
#define YA P_BF(WS_YA)
#define ODIFF P_BF(WS_ODIFF)
#define YB P_BF(WS_YB)
#define TMP P_BF(WS_TMP)
#define XIN ((const float*)args.in[0])
#define MV(k) (MODV + (k) * 16384)
struct Args { const void* in[23]; float* out; unsigned char* ws; };
__global__ void __launch_bounds__(NWAVES * 64, 2) mk_fwd(Args args) {
    extern __shared__ __attribute__((aligned(16))) unsigned char lds[];
    LAS unsigned char* L = (LAS unsigned char*)lds;
    volatile LAS unsigned* MISC = (volatile LAS unsigned*)(L + MISC_OFF);
    const int tid0 = threadIdx.x;
    const int G = gridDim.x; int vcu; { const int bx = blockIdx.x; vcu = (G % 8 == 0) ? (bx % 8) * (G / 8) + bx / 8 : bx; }
    gu32* ctl = (gu32*)(args.ws + WS_CTL);
    float* out = args.out;
    for (int u = tid0; u < (LDS_BYTES - LDSCTL_OFF) / 4; u += NWAVES * 64) ((LAS unsigned*)(L + LDSCTL_OFF))[u] = 0u;
    __syncthreads();
    XcdBarrier bar = xcd_barrier_post((unsigned*)(ctl + CW_BAR), MISC + 8);
#define GRID_BAR() xcd_barrier(bar)

    { PH_BEGIN
        const int gw = vcu * NWAVES + wave, NGW = G * NWAVES;
        const float* cvec = (const float*)args.in[1]; const int* pos = (const int*)args.in[2];
        LAS float* scr = (LAS float*)(L + RING_OFF + wave * 16384);
        constexpr int T_ADA = KCH * (NADA / 256), T_FADA = KCH * (NFADA / 256);
        constexpr int I_FIN = (DM / 64) * (NFF2 / 32), I_FOUT = (DFF / 64) * (DM / 32), I_WIN = (DM / 64) * ((INCOLS + 31) / 32), I_WO = (2048 / 64) * (DM / 32), I_WOUT = (DM / 64) * (DM / 32);
        constexpr int NITEMS = T_ADA + T_FADA + 2 * I_FIN + 2 * I_FOUT + I_WIN + 2 * I_WO + I_WOUT;
        for (int it = gw; it < NITEMS; it += NGW) {
            int r = it;
            if (r < T_ADA) { gemv_task((const float*)args.in[3], NADA, cvec, PART, 0, r, scr, lane); continue; } r -= T_ADA;
            if (r < T_FADA) { gemv_task((const float*)args.in[20], NFADA, cvec, PART, NADA, r, scr, lane); continue; } r -= T_FADA;
            if (r < I_FIN) { p0_transpose_item((const float*)args.in[6], DM, NFF2, MapGlu{W1IN}, scr, r, lane); continue; } r -= I_FIN;
            if (r < I_FOUT) { p0_transpose_item((const float*)args.in[7], DFF, DM, MapId{W1OUT, DFF}, scr, r, lane); continue; } r -= I_FOUT;
            if (r < I_WIN) { p0_transpose_item((const float*)args.in[9], DM, INCOLS, MapWin{WIN, WFF}, scr, r, lane); continue; } r -= I_WIN;
            if (r < I_WO) { p0_transpose_item((const float*)args.in[14], 2048, DM, MapId{WOFOX, 2048}, scr, r, lane); continue; } r -= I_WO;
            if (r < I_WO) { p0_transpose_item((const float*)args.in[15], 2048, DM, MapId{WODIFF, 2048}, scr, r, lane); continue; } r -= I_WO;
            if (r < I_WOUT) { p0_transpose_item((const float*)args.in[16], DM, DM, MapId{WOUT, DM}, scr, r, lane); continue; } r -= I_WOUT;
            if (r < I_FIN) { p0_transpose_item((const float*)args.in[18], DM, NFF2, MapGlu{W2IN}, scr, r, lane); continue; } r -= I_FIN;
            p0_transpose_item((const float*)args.in[19], DFF, DM, MapId{W2OUT, DFF}, scr, r, lane);
        }
        for (int i = vcu * NWAVES * 64 + tid; i < M * 16; i += G * NWAVES * 64) { const int m = i >> 4, j = i & 15; float c, s; sincos_f64((float)pos[m] * c_inv_freq[j], c, s); ROPEC[i] = c; ROPES[i] = s; }
    }
    GRID_BAR();
    { PH_BEGIN
      for (int idx = vcu * NWAVES * 64 + tid; idx < 11 * 4 * DM; idx += G * NWAVES * 64) {
        const int q = idx >> 14, r = idx & 16383, b = r >> 12, col = r & 4095;
        const int ncol = q < 9 ? q * DM + col : NADA + (q - 9) * DM + col;
        float s = q < 9 ? ((const float*)args.in[4])[q * DM + col] : ((const float*)args.in[21])[(q - 9) * DM + col];
#pragma unroll 8
        for (int kc = 0; kc < KCH; ++kc) s += PART[(size_t)(kc * 4 + b) * NMODC + ncol];
        float o = s;
        if (q == 1) o = ((const float*)args.in[5])[col] * (1.f + s); else if (q == 4) o = ((const float*)args.in[8])[col] * (1.f + s); else if (q == 7) o = ((const float*)args.in[17])[col] * (1.f + s);
        else if (q == 10) o = ((const float*)args.in[22])[col] * (1.f + s); else if (q == 2 || q == 8) o = 0.5f * s;
        MODV[idx] = o;
      } }
    GRID_BAR();

#if ST_FFN1
    { PH_BEGIN norm_phase<false>(XIN, HB, MV(1), MV(0), L + RING_OFF, vcu, G, tid, wave, lane, false); }
    GRID_BAR();
    { PH_BEGIN pg8::Gemm g{HB, W1IN, M, NFF2, DM}; pg8::StaticOrder S; S.init(M, NFF2, G, (int)blockIdx.x); pg8::EpiSwiGLU E{ACT, DFF};
      pg8::gemm_phase<pg8::EpiSwiGLU, pg8::StaticOrder, true, true>(L + RING_OFF, g, S, E); }
    GRID_BAR();
    { PH_BEGIN pg8::Gemm g{ACT, W1OUT, M, DM, DFF}; pg8::StaticOrder S; S.init(M, DM, G, (int)blockIdx.x); pg8::EpiResid E{XIN, out, MV(2)};
      pg8::gemm_phase<pg8::EpiResid, pg8::StaticOrder, true, true>(L + RING_OFF, g, S, E); }
    GRID_BAR();
#else
    { PH_BEGIN for (size_t i = (size_t)(vcu * NWAVES * 64 + tid); i < (size_t)M * DM / 4; i += (size_t)G * NWAVES * 64) ((GAS f32x4*)out)[i] = ((const GAS f32x4*)XIN)[i]; }
    GRID_BAR();
#endif

#if ST_MIX
    { PH_BEGIN norm_phase<false>(out, HB, MV(4), MV(3), L + RING_OFF, vcu, G, tid, wave, lane, false); }
    GRID_BAR();
#if !ST_P5
    { PH_BEGIN for (size_t i = (size_t)(vcu * NWAVES * 64 + tid); i < (size_t)M * 8192 * 2 / 16; i += (size_t)G * NWAVES * 64) ((GAS v4u*)GATES)[i] = (v4u){0x3f003f00u, 0x3f003f00u, 0x3f003f00u, 0x3f003f00u}; }
    GRID_BAR();
    GRID_BAR();
#else
    { PH_BEGIN pg8::Gemm g{HB, WIN, M, NPROJ, DM}; pg8::StaticOrder S; S.init(M, NPROJ, G, (int)blockIdx.x); pg8::EpiProj E{QKV, GATES, (const float*)args.in[11], ROPEC, ROPES};
      pg8::gemm_phase<pg8::EpiProj, pg8::StaticOrder, true, true>(L + RING_OFF, g, S, E); }
#if ST_FF
    { PH_BEGIN ff_phase(HB, WFF, (const float*)args.in[10], LOGF, vcu, G, wave, lane); }
#endif
    GRID_BAR();
#if ST_FF
    { PH_BEGIN cumsum_phase(LOGF, KBIAS, L + RING_OFF, vcu, G, tid, wave, lane); }
#endif
    GRID_BAR();
#endif
#if defined(ST_PROBE) && ST_PROBE == 1
    { PH_BEGIN for (size_t i = (size_t)(vcu * NWAVES * 64 + tid); i < (size_t)M * DM; i += (size_t)G * NWAVES * 64) { const size_t m = i >> 12, c = i & 4095; out[i] = __builtin_bit_cast(float, (unsigned)GATES[m * 8192 + 4096 + c] << 16); } }
    return;
#endif
#if !ST_ATT
    { PH_BEGIN for (size_t i = (size_t)(vcu * NWAVES * 64 + tid); i < (size_t)M * 2048 * 2 / 16; i += (size_t)G * NWAVES * 64) ((GAS v4u*)YA)[i] = (v4u){0u, 0u, 0u, 0u};
      for (size_t i = (size_t)(vcu * NWAVES * 64 + tid); i < (size_t)M * 4096 * 2 / 16; i += (size_t)G * NWAVES * 64) ((GAS v4u*)ODIFF)[i] = (v4u){0x3f803f80u, 0x3f803f80u, 0x3f803f80u, 0x3f803f80u}; }
#else
    { PH_BEGIN
        constexpr int TOTAL = (64 + 128) * 8;
        const int cc = (G % 8 == 0) ? ((int)blockIdx.x % 8) * (G / 8) + (int)blockIdx.x / 8 : (int)blockIdx.x;
        const int nit = cc < TOTAL ? (TOTAL - 1 - cc) / G + 1 : 0;
        if (nit > 0) {
            att::Seam SM; att::BlockRef cur = att_ref(ws, 0, G, cc);
            att::block_prime(cur, (char*)lds + RING_OFF, SM);
            for (int j = 0; j < 2 * nit; ++j) { const att::BlockRef nxt = (j + 1 < 2 * nit) ? att_ref(ws, j + 1, G, cc) : cur;
                att::block_run(cur, nxt, (char*)lds + RING_OFF, SM); cur = nxt; }
        }
    }
#endif
    GRID_BAR();
    { PH_BEGIN diffcomb_phase(ODIFF, YB, (const float*)args.in[12], (const float*)args.in[13], vcu, G, wave, lane); }
    GRID_BAR();
#if !ST_MA
    { PH_BEGIN for (size_t i = (size_t)(vcu * NWAVES * 64 + tid); i < (size_t)M * 4096 * 2 / 16; i += (size_t)G * NWAVES * 64) ((GAS v4u*)TMP)[i] = (v4u){0u, 0u, 0u, 0u}; }
    GRID_BAR();
#else
    { PH_BEGIN pg8::Gemm g{YA, WOFOX, M, DM, 2048}; pg8::StaticOrder S; S.init(M, DM, G, (int)blockIdx.x); pg8::EpiMerge<true> E{GATES, 0, nullptr, TMP};
      pg8::gemm_phase<pg8::EpiMerge<true>, pg8::StaticOrder, true, true>(L + RING_OFF, g, S, E); }
#endif
    { PH_BEGIN pg8::Gemm g{YB, WODIFF, M, DM, 2048}; pg8::StaticOrder S; S.init(M, DM, G, (int)blockIdx.x); pg8::EpiMerge<false> E{GATES, 4096, TMP, HB};
      pg8::gemm_phase<pg8::EpiMerge<false>, pg8::StaticOrder, true, true>(L + RING_OFF, g, S, E); }
    GRID_BAR();
    { PH_BEGIN pg8::Gemm g{HB, WOUT, M, DM, DM}; pg8::StaticOrder S; S.init(M, DM, G, (int)blockIdx.x); pg8::EpiResid E{out, out, MV(5)};
      pg8::gemm_phase<pg8::EpiResid, pg8::StaticOrder, true, true>(L + RING_OFF, g, S, E); }
    GRID_BAR();
#endif

#if ST_FFN2
    { PH_BEGIN norm_phase<false>(out, HB, MV(7), MV(6), L + RING_OFF, vcu, G, tid, wave, lane, false); }
    GRID_BAR();
    { PH_BEGIN pg8::Gemm g{HB, W2IN, M, NFF2, DM}; pg8::StaticOrder S; S.init(M, NFF2, G, (int)blockIdx.x); pg8::EpiSwiGLU E{ACT, DFF};
      pg8::gemm_phase<pg8::EpiSwiGLU, pg8::StaticOrder, true, true>(L + RING_OFF, g, S, E); }
    GRID_BAR();
    { PH_BEGIN pg8::Gemm g{ACT, W2OUT, M, DM, DFF}; pg8::StaticOrder S; S.init(M, DM, G, (int)blockIdx.x); pg8::EpiResid E{out, out, MV(8)};
      pg8::gemm_phase<pg8::EpiResid, pg8::StaticOrder, true, true>(L + RING_OFF, g, S, E); }
    GRID_BAR();
#endif
    { PH_BEGIN const bool poison = __hip_atomic_load((gu32*)(ctl + CW_BAR + XB_TMO), RLX_AGENT) != 0u;
      norm_phase<true>(out, out, MV(10), MV(9), L + RING_OFF, vcu, G, tid, wave, lane, poison); }
}

extern "C" void kernel_launch(void* const* d_in, const int* in_sizes, int n_in, void* d_out, int out_size, void* d_ws, size_t ws_size, hipStream_t stream) {
    static int grid = 0;
    if (grid == 0) {
        if (n_in != 23 || in_sizes[0] != M * DM || out_size != M * DM || ws_size < WS_END) { fprintf(stderr, "kernel_launch: unexpected shapes (n_in %d, in0 %d, out %d, ws %zu < %zu); nothing launched\n", n_in, n_in > 0 ? in_sizes[0] : -1, out_size, ws_size, (size_t)WS_END); grid = -1; return; }
        int dev = 0, cus = 0, per_cu = 0;
        if (hipGetDevice(&dev) != hipSuccess || hipDeviceGetAttribute(&cus, hipDeviceAttributeMultiprocessorCount, dev) != hipSuccess) { fprintf(stderr, "kernel_launch: device query failed\n"); grid = -1; return; }
        if (hipFuncSetAttribute((const void*)mk_fwd, hipFuncAttributeMaxDynamicSharedMemorySize, LDS_BYTES) != hipSuccess) { fprintf(stderr, "kernel_launch: hipFuncSetAttribute failed\n"); grid = -1; return; }
        if (hipOccupancyMaxActiveBlocksPerMultiprocessor(&per_cu, (const void*)mk_fwd, NWAVES * 64, LDS_BYTES) != hipSuccess || per_cu < 1) fprintf(stderr, "kernel_launch: note: occupancy query reports %d workgroups per CU\n", per_cu);
        (void)hipGetLastError();
        grid = cus;
    }
    if (grid < 0) return;
    if (hipMemsetAsync((char*)d_ws + WS_CTL, 0, CTL_ZERO_BYTES, stream) != hipSuccess) { fprintf(stderr, "kernel_launch: memset failed\n"); return; }
    Args a{};
    for (int i = 0; i < 23; ++i) a.in[i] = d_in[i];
    a.out = (float*)d_out; a.ws = (unsigned char*)d_ws;
    hipLaunchKernelGGL(mk_fwd, dim3(grid), dim3(NWAVES * 64), LDS_BYTES, stream, a);
    const hipError_t le = hipPeekAtLastError();
    if (le != hipSuccess) fprintf(stderr, "kernel_launch: launch failed: %s\n", hipGetErrorName(le));
}
```

```cpp
#include <hip/hip_runtime.h>
#include <hip/hip_bf16.h>
#include <cstdio>
#include <cstdint>
namespace pg8 {
#define PG8_LAS __attribute__((address_space(3)))
typedef unsigned short bf16_t;
typedef short bf16x8 __attribute__((ext_vector_type(8)));
typedef float f32x4 __attribute__((ext_vector_type(4)));
typedef unsigned u32x4 __attribute__((ext_vector_type(4)));
constexpr int BM = 256, BK = 64, HALF = 128, HTB = HALF * BK * 2  , STAGE_BYTES = 8 * HTB, NXCD = 8, WGM = 8;

__host__ __device__ __forceinline__ int lds_byte(int r, int c) { const int st = (r >> 4) * 2 + (c >> 5), rr = r & 15, cc = c & 31, ob = rr * 64 + cc * 2; return st * 1024 + (ob ^ (((ob >> 9) & 1) << 5)); }
__host__ __device__ __forceinline__ void stage_rc(int b, int& R, int& C) { const int st = b / 1024, sb = b % 1024, swz = sb ^ (((sb >> 9) & 1) << 5); R = (st >> 1) * 16 + swz / 64; C = (st & 1) * 32 + (swz % 64) / 2; }
__host__ __device__ __forceinline__ int perm32(int rho) { const int n = rho >> 4, i = rho & 15; return 8 * (i >> 2) + 4 * n + (i & 3); }

struct Unit { int pm, pn; };
struct Gemm { const bf16_t* A; const bf16_t* Bt; int M, N, K, ld = 0, ablk = 0; };

struct StaticOrder {
    int nM, nN, nwg, G, c;
    __host__ __device__ void init(int M, int N, int G_, int c_) { nM = M / BM; nN = N / BM; nwg = nM * nN; G = G_; c = c_; }
    __host__ __device__ bool next(int i, Unit& u) const {
        const long L = (long)i * G + c; if (L >= nwg) return false;
        int wgid = (int)L; { const int q = nwg / NXCD, r = nwg % NXCD, xcd = wgid % NXCD, off = wgid / NXCD; wgid = (xcd < r ? xcd * (q + 1) : r * (q + 1) + (xcd - r) * q) + off; }
        const int nig = WGM * nN, gid = wgid / nig, fm = gid * WGM, gsz = (nM - fm) < WGM ? (nM - fm) : WGM;
        u.pm = fm + ((wgid % nig) % gsz); u.pn = (wgid % nig) / gsz; return true;
    }
    __device__ __forceinline__ void a_ready(const Unit&) const {}
    __device__ __forceinline__ void done(const Unit&) const {}
};
struct LimitedOrder : StaticOrder { int maxi; __host__ __device__ bool next(int i, Unit& u) const { return i < maxi && StaticOrder::next(i, u); } };
struct OneUnitOrder : StaticOrder { int round, cu; __host__ __device__ bool next(int i, Unit& u) const { if (i != 0) return false; StaticOrder t = *this; t.c = cu; return t.next(round, u); } };
typedef __bf16 bf16x2_t __attribute__((ext_vector_type(2)));
typedef float f32x2_t __attribute__((ext_vector_type(2)));
__device__ __forceinline__ unsigned cvt_pk_bf16(float lo, float hi) { const f32x2_t v = {lo, hi}; const bf16x2_t b = __builtin_convertvector(v, bf16x2_t); return __builtin_bit_cast(unsigned, b); }
typedef float f32x2 __attribute__((ext_vector_type(2)));
__device__ __forceinline__ float sigm(float x) { return __builtin_amdgcn_rcpf(1.f + __builtin_amdgcn_exp2f(-1.4426950408889634f * x)); }
__device__ __forceinline__ u32x4 pack8(f32x4 a, f32x4 b) { u32x4 w; w.x = cvt_pk_bf16(a[0], a[1]); w.y = cvt_pk_bf16(a[2], a[3]); w.z = cvt_pk_bf16(b[0], b[1]); w.w = cvt_pk_bf16(b[2], b[3]); return w; }
__device__ __forceinline__ void unpack8(u32x4 w, f32x4& a, f32x4& b) {
    a[0] = __builtin_bit_cast(float, w.x << 16); a[1] = __builtin_bit_cast(float, w.x & 0xffff0000u); a[2] = __builtin_bit_cast(float, w.y << 16); a[3] = __builtin_bit_cast(float, w.y & 0xffff0000u);
    b[0] = __builtin_bit_cast(float, w.z << 16); b[1] = __builtin_bit_cast(float, w.z & 0xffff0000u); b[2] = __builtin_bit_cast(float, w.w << 16); b[3] = __builtin_bit_cast(float, w.w & 0xffff0000u); }

struct EpiSwiGLU {
    static constexpr bool PERM = true, AFTER_DRAIN = false;
    bf16_t* O; int ldc;
    __device__ __forceinline__ void operator()(const f32x4 (&acc)[2][2][4][2], const Unit& u, int wr, int wc, int fr, int fq) const {
        const int row0 = u.pm * BM + wr * 64 + fr, col0 = u.pn * HALF + wc * 32 + 8 * fq;
#pragma unroll
        for (int ai = 0; ai < 2; ++ai)
#pragma unroll
            for (int m = 0; m < 4; ++m) { bf16_t* rowp = O + ((size_t)u.pm * (ldc >> 6) + (col0 >> 6)) * (BM * 64) + (size_t)(wr * 64 + fr + ai * HALF + m * 16) * 64 + (col0 & 63);
                f32x4 v[2];
#pragma unroll
                for (int n = 0; n < 2; ++n) { const f32x4 g = acc[ai][0][m][n], up = acc[ai][1][m][n];
#pragma unroll
                    for (int i = 0; i < 4; ++i) v[n][i] = g[i] * up[i] * sigm(g[i]); }
                *(u32x4*)rowp = pack8(v[0], v[1]); }
    }
};

struct EpiSlabStore {
    static constexpr bool PERM = true, AFTER_DRAIN = false;
    float* slab; unsigned* flag;
    __device__ __forceinline__ void operator()(const f32x4 (&acc)[2][2][4][2], const Unit&, int wr, int wc, int fr, int fq) const {
        f32x4* sp = (f32x4*)slab + (size_t)(wr * 4 + wc) * 32 * 64 + (fq * 16 + fr);
#pragma unroll
        for (int ai = 0; ai < 2; ++ai)
#pragma unroll
            for (int bj = 0; bj < 2; ++bj)
#pragma unroll
                for (int m = 0; m < 4; ++m)
#pragma unroll
                    for (int n = 0; n < 2; ++n) sp[(((ai * 2 + bj) * 4 + m) * 2 + n) * 64] = acc[ai][bj][m][n];
        asm volatile("s_waitcnt vmcnt(0)" ::: "memory"); __builtin_amdgcn_s_barrier(); asm volatile("" ::: "memory");
        if (wr == 0 && wc == 0 && fr == 0 && fq == 0) { __builtin_amdgcn_fence(__ATOMIC_RELEASE, "agent"); asm volatile("s_waitcnt vmcnt(0)" ::: "memory");
            __hip_atomic_store(flag, 1u, __ATOMIC_RELAXED, __HIP_MEMORY_SCOPE_AGENT); }
    }
};
struct EpiSlabSwiGLU {
    static constexpr bool PERM = true, AFTER_DRAIN = false;
    bf16_t* O; int ldc; const float* slab; unsigned* flag; unsigned* tmo;
    __device__ __forceinline__ void operator()(const f32x4 (&acc)[2][2][4][2], const Unit& u, int wr, int wc, int fr, int fq) const {
        if (wr == 0 && wc == 0 && fr == 0 && fq == 0) { unsigned sp = 0;
            while (__hip_atomic_load(flag, __ATOMIC_RELAXED, __HIP_MEMORY_SCOPE_AGENT) == 0u) { __builtin_amdgcn_s_sleep(1);
                if ((++sp & 255u) == 0u) { if (__hip_atomic_load(tmo, __ATOMIC_RELAXED, __HIP_MEMORY_SCOPE_AGENT)) break; if (sp > (1u << 18)) { atomicAdd(tmo, 1u); break; } } }
            __builtin_amdgcn_fence(__ATOMIC_ACQUIRE, "agent"); asm volatile("s_waitcnt vmcnt(0)" ::: "memory"); }
        asm volatile("" ::: "memory"); __builtin_amdgcn_s_barrier(); asm volatile("" ::: "memory");
        const f32x4* sp = (const f32x4*)slab + (size_t)(wr * 4 + wc) * 32 * 64 + (fq * 16 + fr);
        const int row0 = u.pm * BM + wr * 64 + fr, col0 = u.pn * HALF + wc * 32 + 8 * fq;
#pragma unroll
        for (int ai = 0; ai < 2; ++ai)
#pragma unroll
            for (int m = 0; m < 4; ++m) { bf16_t* rowp = O + ((size_t)u.pm * (ldc >> 6) + (col0 >> 6)) * (BM * 64) + (size_t)(wr * 64 + fr + ai * HALF + m * 16) * 64 + (col0 & 63);
                f32x4 v[2];
#pragma unroll
                for (int n = 0; n < 2; ++n) { const f32x4 g = acc[ai][0][m][n] + sp[(((ai * 2 + 0) * 4 + m) * 2 + n) * 64], up = acc[ai][1][m][n] + sp[(((ai * 2 + 1) * 4 + m) * 2 + n) * 64];
#pragma unroll
                    for (int i = 0; i < 4; ++i) v[n][i] = g[i] * up[i] * sigm(g[i]); }
                *(u32x4*)rowp = pack8(v[0], v[1]); }
    }
};

struct EpiResid {
    static constexpr bool PERM = false, AFTER_DRAIN = false;
    const float* R; float* C; const float* gv;
    __device__ __forceinline__ void operator()(const f32x4 (&acc)[2][2][4][2], const Unit& u, int wr, int wc, int fr, int fq) const {
        const int row0 = u.pm * BM + wr * 64 + fr, col0 = u.pn * BM + wc * 32 + 4 * fq; const int b = u.pm >> 4;
        f32x4 g[2][2];
#pragma unroll
        for (int bj = 0; bj < 2; ++bj)
#pragma unroll
            for (int n = 0; n < 2; ++n) g[bj][n] = *(const f32x4*)(gv + b * 4096 + col0 + bj * HALF + n * 16);
#pragma unroll
        for (int ai = 0; ai < 2; ++ai)
#pragma unroll
            for (int m = 0; m < 4; ++m) { const size_t off = (size_t)(row0 + ai * HALF + m * 16) * 4096 + col0;
#pragma unroll
                for (int bj = 0; bj < 2; ++bj)
#pragma unroll
                    for (int n = 0; n < 2; ++n) { const f32x4 r = *(const f32x4*)(R + off + bj * HALF + n * 16); *(f32x4*)(C + off + bj * HALF + n * 16) = r + g[bj][n] * acc[ai][bj][m][n]; } }
    }
};

template <bool R_F32> struct EpiResidB {
    static constexpr bool PERM = true, AFTER_DRAIN = false;
    const void* R; bf16_t* C; const float* gv;
    __device__ __forceinline__ void operator()(const f32x4 (&acc)[2][2][4][2], const Unit& u, int wr, int wc, int fr, int fq) const {
        const int row0 = u.pm * BM + wr * 64 + fr, col0 = u.pn * BM + wc * 32 + 8 * fq; const int b = u.pm >> 4;
        f32x4 g[2][2];
#pragma unroll
        for (int bj = 0; bj < 2; ++bj)
#pragma unroll
            for (int n = 0; n < 2; ++n) g[bj][n] = *(const f32x4*)(gv + b * 4096 + col0 + bj * HALF + 4 * n);
#pragma unroll
        for (int ai = 0; ai < 2; ++ai)
#pragma unroll
            for (int m = 0; m < 4; ++m) { const size_t off = (size_t)(row0 + ai * HALF + m * 16) * 4096 + col0;
#pragma unroll
                for (int bj = 0; bj < 2; ++bj) { f32x4 r0, r1;
                    if (R_F32) { r0 = *(const f32x4*)((const float*)R + off + bj * HALF); r1 = *(const f32x4*)((const float*)R + off + bj * HALF + 4); }
                    else unpack8(*(const u32x4*)((const bf16_t*)R + off + bj * HALF), r0, r1);
                    *(u32x4*)(C + off + bj * HALF) = pack8(r0 + g[bj][0] * acc[ai][bj][m][0], r1 + g[bj][1] * acc[ai][bj][m][1]); } }
    }
};

struct EpiProj {
    static constexpr bool PERM = true, AFTER_DRAIN = false;
    bf16_t* qkv; bf16_t* gates; const float* bgate; const float* ropec; const float* ropes;
    __device__ __forceinline__ void operator()(const f32x4 (&acc)[2][2][4][2], const Unit& u, int wr, int wc, int fr, int fq) const {
        const int t = u.pn >> 3, b = u.pm >> 4, s0 = (u.pm & 15) * 256 + wr * 64 + fr;
        if (t < 6) {
            bf16_t* base = qkv + (size_t)t * ((size_t)16384 * 2048);
            const bool rope = (t == 3 || t == 4) && wc == 0;
#pragma unroll
            for (int bj = 0; bj < 2; ++bj) { const int head = (u.pn & 7) * 2 + bj; bf16_t* hb = base + (size_t)(b * 16 + head) * 4096 * 128;
#pragma unroll
                for (int ai = 0; ai < 2; ++ai)
#pragma unroll
                    for (int m = 0; m < 4; ++m) { const int s = s0 + ai * HALF + m * 16; bf16_t* p = hb + (size_t)s * 128;
                        const f32x4 v0 = acc[ai][bj][m][0], v1 = acc[ai][bj][m][1];
                        if (rope) { const size_t ri = ((size_t)b * 4096 + s) * 16 + 4 * fq; const f32x4 cs = *(const f32x4*)(ropec + ri), sn = *(const f32x4*)(ropes + ri);
                            const f32x4 lo = v0 * cs - v1 * sn, hi = v1 * cs + v0 * sn;
                            typedef unsigned u32x2 __attribute__((ext_vector_type(2)));
                            u32x2 a, c2; a.x = cvt_pk_bf16(lo[0], lo[1]); a.y = cvt_pk_bf16(lo[2], lo[3]); c2.x = cvt_pk_bf16(hi[0], hi[1]); c2.y = cvt_pk_bf16(hi[2], hi[3]);
                            *(u32x2*)(p + 4 * fq) = a; *(u32x2*)(p + 16 + 4 * fq) = c2; }
                        else *(u32x4*)(p + wc * 32 + 8 * fq) = pack8(v0, v1); } }
        } else {
            const int row0 = u.pm * BM + wr * 64 + fr, col0 = (u.pn - 48) * BM + wc * 32 + 8 * fq;
            f32x4 bv[2][2];
#pragma unroll
            for (int bj = 0; bj < 2; ++bj)
#pragma unroll
                for (int n = 0; n < 2; ++n) bv[bj][n] = *(const f32x4*)(bgate + col0 + bj * HALF + 4 * n);
#pragma unroll
            for (int ai = 0; ai < 2; ++ai)
#pragma unroll
                for (int m = 0; m < 4; ++m) { bf16_t* rowp = gates + ((size_t)(u.pm * 32 + (u.pn - 48)) * 65536 + (wr * 4 + wc) * 8192 + (ai * 4 + m) * 1024 + (fq * 16 + fr) * 8);
#pragma unroll
                    for (int bj = 0; bj < 2; ++bj) { f32x4 v0 = acc[ai][bj][m][0] + bv[bj][0], v1 = acc[ai][bj][m][1] + bv[bj][1];
#pragma unroll
                        for (int i = 0; i < 4; ++i) { v0[i] = sigm(v0[i]); v1[i] = sigm(v1[i]); }
                        *(u32x4*)(rowp + bj * 512) = pack8(v0, v1); } }
        }
    }
};

template <bool FIRST> struct EpiMerge {
    static constexpr bool PERM = true, AFTER_DRAIN = false;
    const bf16_t* G; int goff; const bf16_t* T; bf16_t* O;
    __device__ __forceinline__ void operator()(const f32x4 (&acc)[2][2][4][2], const Unit& u, int wr, int wc, int fr, int fq) const {
        const int row0 = u.pm * BM + wr * 64 + fr, col0 = u.pn * BM + wc * 32 + 8 * fq;
#pragma unroll
        for (int ai = 0; ai < 2; ++ai)
#pragma unroll
            for (int m = 0; m < 4; ++m) { const size_t row = (size_t)(row0 + ai * HALF + m * 16);
#pragma unroll
                for (int bj = 0; bj < 2; ++bj) { f32x4 g0, g1; unpack8(*(const u32x4*)(G + ((size_t)(u.pm * 32 + (goff >> 8) + u.pn) * 65536 + (wr * 4 + wc) * 8192 + ((ai * 4 + m) * 2 + bj) * 512 + (fq * 16 + fr) * 8)), g0, g1);
                    f32x4 v0 = g0 * acc[ai][bj][m][0], v1 = g1 * acc[ai][bj][m][1];
                    if (!FIRST) { f32x4 t0, t1; unpack8(*(const u32x4*)(T + row * 4096 + col0 + bj * HALF), t0, t1); v0 += t0; v1 += t1; }
                    *(u32x4*)(O + row * 4096 + col0 + bj * HALF) = pack8(v0, v1); } }
    }
};

template <class Epi, class Sched, bool ALIGN_EPI = false, bool SP2 = false>
__device__ __forceinline__ void gemm_phase(PG8_LAS unsigned char* lds, const Gemm g, const Sched& S, const Epi& E) {
    int tid_l = threadIdx.x; asm volatile("" : "+v"(tid_l)); const int tid = tid_l, wid = __builtin_amdgcn_readfirstlane(tid >> 6), lane = tid & 63, wr = wid >> 2, wc = wid & 3, fr = lane & 15, fq = lane >> 4;
    const int K = g.ld ? g.ld : g.K, nt = g.K / BK;
    unsigned voffA[2], voffB[2];
#pragma unroll
    for (int i = 0; i < 2; ++i) { int R, C; stage_rc(tid * 16 + i * 8192, R, C); const int Rb = Epi::PERM ? ((R & ~31) + perm32(R & 31)) : R;
        voffA[i] = g.ablk ? (unsigned)(R * BK + C) * 2u : (unsigned)(R * K + C) * 2u; voffB[i] = (unsigned)(Rb * K + C) * 2u; }
    const size_t kstep = (size_t)(BK * 2);
    const size_t hstep = (size_t)HALF * K * 2;
    const size_t tstep = 2 * hstep;
    const size_t kstepA = g.ablk ? (size_t)(BM * BK * 2) : kstep, hstepA = g.ablk ? (size_t)(HALF * BK * 2) : hstep;
    const unsigned ldsw = (unsigned)wid * 1024u;
    const int aoff = lds_byte(wr * 64 + fr, fq * 8), boff = lds_byte(wc * 32 + fr, fq * 8);
#define PG8_SA(b, h) (((b) * 2 + (h)) * HTB)
#define PG8_SB(b, h) ((4 + (b) * 2 + (h)) * HTB)
#define PG8_STAGE(bufoff, gbase, voff) do { _Pragma("unroll") for (int _i = 0; _i < 2; ++_i) \
        __builtin_amdgcn_global_load_lds((const unsigned*)((const char*)(gbase) + (voff)[_i]), (PG8_LAS unsigned*)(lds + (bufoff) + ldsw + _i * 8192), 16, 0, 0); } while (0)
#define PG8_LDA(dst, b, h) do { _Pragma("unroll") for (int m = 0; m < 4; ++m) _Pragma("unroll") for (int k = 0; k < 2; ++k) dst[m][k] = *(const PG8_LAS bf16x8*)(lds + PG8_SA(b, h) + aoff + m * 2048 + k * 1024); } while (0)
#define PG8_LDB(dst, b, h) do { _Pragma("unroll") for (int n = 0; n < 2; ++n) _Pragma("unroll") for (int k = 0; k < 2; ++k) dst[n][k] = *(const PG8_LAS bf16x8*)(lds + PG8_SB(b, h) + boff + n * 2048 + k * 1024); } while (0)
#define PG8_MMA(ai, bj, At, Bt) do { __builtin_amdgcn_s_setprio(1); _Pragma("unroll") for (int m = 0; m < 4; ++m) _Pragma("unroll") for (int n = 0; n < 2; ++n) _Pragma("unroll") for (int k = 0; k < 2; ++k) \
        acc[ai][bj][m][n] = __builtin_amdgcn_mfma_f32_16x16x32_bf16(Bt[n][k], At[m][k], acc[ai][bj][m][n], 0, 0, 0); __builtin_amdgcn_s_setprio(0); } while (0)
#define PG8_WAIT_V(n) asm volatile("s_waitcnt vmcnt(" #n ")" ::: "memory")
#define PG8_WAIT_L(n) asm volatile("s_waitcnt lgkmcnt(" #n ")" ::: "memory")
#define PG8_BAR __builtin_amdgcn_s_barrier()
#define PG8_SCHED __builtin_amdgcn_sched_barrier(0)
    Unit cur, nxt; int ui = 0;
    if (!S.next(0, cur)) return;
    f32x4 acc[2][2][4][2];
#pragma unroll
    for (int a = 0; a < 2; ++a)
#pragma unroll
        for (int b = 0; b < 2; ++b)
#pragma unroll
            for (int m = 0; m < 4; ++m)
#pragma unroll
                for (int n = 0; n < 2; ++n) acc[a][b][m][n] = (f32x4){0.f, 0.f, 0.f, 0.f};
    bf16x8 At[4][2], B0[2][2], B1[2][2];
    const char* cA = (const char*)g.A + (size_t)cur.pm * tstep; const char* cB = (const char*)g.Bt + (size_t)cur.pn * tstep;
    S.a_ready(cur);
    if constexpr (SP2) {
        PG8_STAGE(PG8_SB(0, 0), cB, voffB); PG8_STAGE(PG8_SB(0, 1), cB + hstep, voffB); PG8_STAGE(PG8_SA(0, 0), cA, voffA); PG8_STAGE(PG8_SA(0, 1), cA + hstepA, voffA);
        if (wr == 1) PG8_BAR;
        PG8_WAIT_V(2); PG8_BAR;
        PG8_STAGE(PG8_SB(1, 0), cB + kstep, voffB); PG8_STAGE(PG8_SA(1, 0), cA + kstepA, voffA); PG8_STAGE(PG8_SB(1, 1), cB + hstep + kstep, voffB);
        PG8_WAIT_V(6); PG8_BAR;
    } else {
        PG8_STAGE(PG8_SB(0, 0), cB, voffB); PG8_STAGE(PG8_SA(0, 0), cA, voffA); PG8_STAGE(PG8_SB(0, 1), cB + hstep, voffB); PG8_STAGE(PG8_SA(0, 1), cA + hstepA, voffA);
        if (wr == 1) PG8_BAR;
        PG8_WAIT_V(4); PG8_BAR;
        PG8_STAGE(PG8_SB(1, 0), cB + kstep, voffB); PG8_STAGE(PG8_SA(1, 0), cA + kstepA, voffA); PG8_STAGE(PG8_SB(1, 1), cB + hstep + kstep, voffB);
        PG8_WAIT_V(6); PG8_BAR;
    }
    for (;;) {
        const bool has_next = S.next(ui + 1, nxt);
        const char* nA = has_next ? (const char*)g.A + (size_t)nxt.pm * tstep : cA; const char* nB = has_next ? (const char*)g.Bt + (size_t)nxt.pn * tstep : cB;
        for (int t = 0; t < nt; t += 2) {
            const bool last = (t == nt - 2);
            const char* a1 = cA + (size_t)(t + 1) * kstepA;
            const char* a2 = last ? nA : cA + (size_t)(t + 2) * kstepA; const char* b2 = last ? nB : cB + (size_t)(t + 2) * kstep;
            const char* a3 = a2 + kstepA; const char* b3 = b2 + kstep;
            if (last && has_next) S.a_ready(nxt);
            if constexpr (SP2) {
            PG8_LDB(B0, 0, 0); PG8_LDB(B1, 0, 1); PG8_SCHED; PG8_LDA(At, 0, 0); PG8_STAGE(PG8_SA(1, 1), a1 + hstepA, voffA);
            PG8_WAIT_V(8); PG8_WAIT_L(0); PG8_BAR; PG8_MMA(0, 0, At, B0); PG8_MMA(0, 1, At, B1); PG8_BAR; PG8_SCHED;
            PG8_LDA(At, 0, 1); PG8_STAGE(PG8_SB(0, 0), b2, voffB); PG8_STAGE(PG8_SB(0, 1), b2 + hstep, voffB); PG8_STAGE(PG8_SA(0, 0), a2, voffA);
            PG8_WAIT_V(8); PG8_WAIT_L(0); PG8_BAR; PG8_MMA(1, 0, At, B0); PG8_MMA(1, 1, At, B1); PG8_BAR; PG8_SCHED;
            PG8_LDB(B0, 1, 0); PG8_LDB(B1, 1, 1); PG8_SCHED; PG8_LDA(At, 1, 0); PG8_STAGE(PG8_SA(0, 1), a2 + hstepA, voffA);
            PG8_WAIT_V(8); PG8_WAIT_L(0); PG8_BAR; PG8_MMA(0, 0, At, B0); PG8_MMA(0, 1, At, B1); PG8_BAR; PG8_SCHED;
            PG8_LDA(At, 1, 1); PG8_STAGE(PG8_SB(1, 0), b3, voffB); PG8_STAGE(PG8_SB(1, 1), b3 + hstep, voffB); PG8_STAGE(PG8_SA(1, 0), a3, voffA);
            PG8_WAIT_V(8); PG8_WAIT_L(0); PG8_BAR; PG8_MMA(1, 0, At, B0); PG8_MMA(1, 1, At, B1); PG8_BAR; PG8_SCHED;
            } else {
            PG8_LDB(B0, 0, 0); PG8_SCHED; PG8_LDA(At, 0, 0); PG8_STAGE(PG8_SA(1, 1), a1 + hstepA, voffA);
            PG8_WAIT_L(8); PG8_BAR; PG8_WAIT_L(0); PG8_MMA(0, 0, At, B0); PG8_BAR; PG8_SCHED;
            PG8_LDB(B1, 0, 1); PG8_STAGE(PG8_SB(0, 0), b2, voffB);
            PG8_BAR; PG8_WAIT_L(0); PG8_MMA(0, 1, At, B1); PG8_BAR;
            PG8_LDA(At, 0, 1); PG8_STAGE(PG8_SA(0, 0), a2, voffA);
            PG8_BAR; PG8_WAIT_L(0); PG8_MMA(1, 0, At, B0); PG8_BAR; PG8_SCHED;
            PG8_STAGE(PG8_SB(0, 1), b2 + hstep, voffB);
            PG8_WAIT_V(6); PG8_BAR; PG8_MMA(1, 1, At, B1); PG8_BAR;
            PG8_LDB(B0, 1, 0); PG8_SCHED; PG8_LDA(At, 1, 0); PG8_STAGE(PG8_SA(0, 1), a2 + hstepA, voffA);
            PG8_WAIT_L(8); PG8_BAR; PG8_WAIT_L(0); PG8_MMA(0, 0, At, B0); PG8_BAR; PG8_SCHED;
            PG8_LDB(B1, 1, 1); PG8_STAGE(PG8_SB(1, 0), b3, voffB);
            PG8_BAR; PG8_WAIT_L(0); PG8_MMA(0, 1, At, B1); PG8_BAR;
            PG8_LDA(At, 1, 1); PG8_STAGE(PG8_SA(1, 0), a3, voffA);
            PG8_BAR; PG8_WAIT_L(0); PG8_MMA(1, 0, At, B0); PG8_BAR; PG8_SCHED;
            PG8_STAGE(PG8_SB(1, 1), b3 + hstep, voffB);
            PG8_WAIT_V(6); PG8_BAR; PG8_MMA(1, 1, At, B1); PG8_BAR;
            }
        }
        if constexpr (ALIGN_EPI) { if (wr == 0) PG8_BAR; }
        if constexpr (!Epi::AFTER_DRAIN) { E(acc, cur, wr, wc, fr, fq); S.done(cur); }
        if (!has_next) break;
#pragma unroll
        for (int a = 0; a < 2; ++a)
#pragma unroll
            for (int b = 0; b < 2; ++b)
#pragma unroll
                for (int m = 0; m < 4; ++m)
#pragma unroll
                    for (int n = 0; n < 2; ++n) acc[a][b][m][n] = (f32x4){0.f, 0.f, 0.f, 0.f};
        cur = nxt; cA = nA; cB = nB; ++ui;
        if constexpr (ALIGN_EPI) { if (wr == 1) PG8_BAR; }
    }
    PG8_WAIT_V(0);
    if constexpr (!ALIGN_EPI) { if (wr == 0) PG8_BAR; }
    PG8_BAR;
    if constexpr (Epi::AFTER_DRAIN) { E.fused(acc, cur, wr, wc, fr, fq, lds, wid, lane); S.done(cur); }
#undef PG8_SA
#undef PG8_SB
#undef PG8_STAGE
#undef PG8_LDA
#undef PG8_LDB
#undef PG8_MMA
#undef PG8_WAIT_V
#undef PG8_WAIT_L
#undef PG8_BAR
#undef PG8_SCHED
}
}
namespace att {
using bf16 = __hip_bfloat16;
typedef short bf16x8 __attribute__((ext_vector_type(8)));
typedef short s16x4 __attribute__((ext_vector_type(4)));
typedef float f32x16 __attribute__((ext_vector_type(16)));
typedef float f32x4 __attribute__((ext_vector_type(4)));
typedef unsigned u32x4 __attribute__((ext_vector_type(4)));
constexpr int D = 128;
constexpr float SCALE = 0.08838834764831845f;
constexpr float THR = 8.f;
constexpr int NW = 8, QBLK = 32, KVBLK = 64, QB = NW * QBLK;
constexpr int SHM_V = KVBLK * D * 2, SHM_K = KVBLK * D * 2;
constexpr int OFF_WS = 2 * SHM_V + 2 * SHM_K;
constexpr int OFF_BIAS = OFF_WS + NW * 64 * 4;
constexpr int LDS_BYTES = OFF_BIAS + 4096 * 4;
constexpr unsigned WINF = 0x7fffffffu;

#define KSWZ(row, colB) ((row) * 256 + ((colB) ^ (((row) & 7) << 4)))
#define SBAR() __builtin_amdgcn_sched_barrier(0)
__device__ __forceinline__ int v_st(int k, int c) { const int kk = (k & ~0xC) | ((k & 4) << 1) | ((k & 8) >> 1); return ((kk >> 3) * 4 + (c >> 5)) * 512 + ((kk & 7) * 32 + (c & 31)) * 2; }
__device__ __forceinline__ int v_rd_base(int lane) { return ((lane & 3) << 3) | (((lane >> 2) & 3) << 6) | (((lane >> 4) & 1) << 5) | (((lane >> 5) & 1) << 8); }
constexpr int v_rd_off(int d0, int ks, int half) { return d0 * 512 + ks * 4096 + half * 2048; }
__device__ __forceinline__ int crow(int r, int hi) { return (r & 3) + 8 * (r >> 2) + 4 * hi; }
typedef __bf16 bf16x2_t __attribute__((ext_vector_type(2)));
typedef float f32x2_t __attribute__((ext_vector_type(2)));
__device__ __forceinline__ unsigned cvtpk(float lo, float hi) { const f32x2_t v = {lo, hi}; const bf16x2_t b = __builtin_convertvector(v, bf16x2_t); return __builtin_bit_cast(unsigned, b); }
__device__ __forceinline__ bf16x8 load8(const bf16* p) { return *reinterpret_cast<const bf16x8*>(p); }
__device__ __forceinline__ void mask_tile(f32x16& p0, f32x16& p1, int dq, unsigned W) {
    const float NEG = -__builtin_inff();
#pragma unroll
    for (int r = 0; r < 16; ++r) {
        const int c = (r & 3) + 8 * (r >> 2);
        if ((unsigned)(dq - c) >= W) p0[r] = NEG;
        if ((unsigned)(dq - c - 32) >= W) p1[r] = NEG;
    }
}
__device__ __forceinline__ void partialSM(f32x16& p0, f32x16& p1, float& m_reg, float& mn, float& alpha) {
    float pmax = p0[0]; for (int r = 1; r < 16; ++r) pmax = fmaxf(pmax, p0[r]); for (int r = 0; r < 16; ++r) pmax = fmaxf(pmax, p1[r]);
    { auto rr = __builtin_amdgcn_permlane32_swap(__float_as_uint(pmax), __float_as_uint(pmax), false, false);
      pmax = fmaxf(__uint_as_float(rr[0]), __uint_as_float(rr[1])); }
    constexpr float C2 = 1.4426950408889634f * SCALE;
    if (__builtin_expect(__all((pmax - m_reg) * SCALE <= THR), 1)) { mn = m_reg; alpha = 1.f; }
    else { mn = fmaxf(m_reg, pmax); alpha = __builtin_amdgcn_exp2f((m_reg - mn) * C2); m_reg = mn; }
    const float mnL = -mn * C2;
    for (int r = 0; r < 16; ++r) p0[r] = fmaf(p0[r], C2, mnL); for (int r = 0; r < 16; ++r) p1[r] = fmaf(p1[r], C2, mnL);
    for (int r = 0; r < 16; ++r) p0[r] = __builtin_amdgcn_exp2f(p0[r]);
}
__device__ __forceinline__ void finishSM(f32x16& p0, f32x16& p1, float alpha, float& l_reg, bf16x8& pa0, bf16x8& pa1, bf16x8& pa2, bf16x8& pa3) {
    for (int r = 0; r < 16; ++r) p1[r] = __builtin_amdgcn_exp2f(p1[r]);
    float ps = 0; for (int r = 0; r < 16; ++r) ps += p0[r]; for (int r = 0; r < 16; ++r) ps += p1[r];
    { auto rr = __builtin_amdgcn_permlane32_swap(__float_as_uint(ps), __float_as_uint(ps), false, false);
      ps = __uint_as_float(rr[0]) + __uint_as_float(rr[1]); }
    l_reg = l_reg * alpha + ps;
#define PK4(P, B_, OUT) do { unsigned a0 = cvtpk(P[B_+0], P[B_+1]), a1 = cvtpk(P[B_+2], P[B_+3]);                          \
        unsigned b0 = cvtpk(P[B_+4], P[B_+5]), b1 = cvtpk(P[B_+6], P[B_+7]);                                             \
        auto r0 = __builtin_amdgcn_permlane32_swap(a0, b0, false, false); auto r1 = __builtin_amdgcn_permlane32_swap(a1, b1, false, false); \
        u32x4 w = {r0[0], r1[0], r0[1], r1[1]}; OUT = *reinterpret_cast<bf16x8*>(&w); } while (0)
    PK4(p0, 0, pa0); PK4(p0, 8, pa1); PK4(p1, 0, pa2); PK4(p1, 8, pa3);
#undef PK4
}
template <int KB>
__device__ __forceinline__ void qkt(f32x16& p0, f32x16& p1, const char* K_lds, int r32, int hi, const bf16x8* qr, const float* bt) {
    { const f32x4 a0 = *(const f32x4*)(bt), a1 = *(const f32x4*)(bt + 8), a2 = *(const f32x4*)(bt + 16), a3 = *(const f32x4*)(bt + 24);
      const f32x4 c0 = *(const f32x4*)(bt + 32), c1 = *(const f32x4*)(bt + 40), c2 = *(const f32x4*)(bt + 48), c3 = *(const f32x4*)(bt + 56);
      p0 = (f32x16){a0[0], a0[1], a0[2], a0[3], a1[0], a1[1], a1[2], a1[3], a2[0], a2[1], a2[2], a2[3], a3[0], a3[1], a3[2], a3[3]};
      p1 = (f32x16){c0[0], c0[1], c0[2], c0[3], c1[0], c1[1], c1[2], c1[3], c2[0], c2[1], c2[2], c2[3], c3[0], c3[1], c3[2], c3[3]}; }
    const char* kb[4];
#pragma unroll
    for (int dd = 0; dd < 4; ++dd) kb[dd] = K_lds + KB * SHM_K + KSWZ(r32, (dd * 16 + hi * 8) * 2);
#pragma unroll
    for (int d0 = 0; d0 < 8; ++d0) { const char* a = kb[d0 & 3] + (d0 >> 2) * 128;
        bf16x8 b0 = *reinterpret_cast<const bf16x8*>(a);
        bf16x8 b1 = *reinterpret_cast<const bf16x8*>(a + 32 * 256);
        p0 = __builtin_amdgcn_mfma_f32_32x32x16_bf16(b0, qr[d0], p0, 0, 0, 0);
        p1 = __builtin_amdgcn_mfma_f32_32x32x16_bf16(b1, qr[d0], p1, 0, 0, 0); }
}
template <int VB>
__device__ __forceinline__ void pv_tile(f32x16* o, int vb0, bf16x8 pa0, bf16x8 pa1, bf16x8 pa2, bf16x8 pa3) {
#define TRRD(dst, off) asm volatile("ds_read_b64_tr_b16 %0, %1 offset:%2" : "=&v"(dst) : "v"(vb0), "i"(off) : "memory")
#define PV_D0(d0) do { s16x4 l0, l1, l2, l3, h0, h1, h2, h3; constexpr int b_ = VB * SHM_V + v_rd_off(d0, 0, 0);   \
        TRRD(l0, b_); TRRD(h0, b_ + 2048); TRRD(l1, b_ + 4096); TRRD(h1, b_ + 6144); TRRD(l2, b_ + 8192); TRRD(h2, b_ + 10240); TRRD(l3, b_ + 12288); TRRD(h3, b_ + 14336); \
        asm volatile("s_waitcnt lgkmcnt(0)" ::: "memory"); SBAR();   \
        o[d0] = __builtin_amdgcn_mfma_f32_32x32x16_bf16(pa0, (bf16x8){l0[0], l0[1], l0[2], l0[3], h0[0], h0[1], h0[2], h0[3]}, o[d0], 0, 0, 0);   \
        o[d0] = __builtin_amdgcn_mfma_f32_32x32x16_bf16(pa1, (bf16x8){l1[0], l1[1], l1[2], l1[3], h1[0], h1[1], h1[2], h1[3]}, o[d0], 0, 0, 0);   \
        o[d0] = __builtin_amdgcn_mfma_f32_32x32x16_bf16(pa2, (bf16x8){l2[0], l2[1], l2[2], l2[3], h2[0], h2[1], h2[2], h2[3]}, o[d0], 0, 0, 0);   \
        o[d0] = __builtin_amdgcn_mfma_f32_32x32x16_bf16(pa3, (bf16x8){l3[0], l3[1], l3[2], l3[3], h3[0], h3[1], h3[2], h3[3]}, o[d0], 0, 0, 0); } while (0)
    PV_D0(0); PV_D0(1); PV_D0(2); PV_D0(3);
#undef PV_D0
#undef TRRD
}

struct BlockRef { const bf16* Q; const bf16* K; const bf16* V; bf16* O; const float* kb; int P0, opitch, CH, jlo; };
struct Seam { bf16x8 qr[8]; bf16x8 st_v0, st_v1, st_k0, st_k1; };
#define ROW(p, k0, rr) ((p) + (size_t)((k0) + (rr)) * D + sc)
#define VMW() asm volatile("s_waitcnt vmcnt(0)" ::: "memory")
#define VMWN(n) asm volatile("s_waitcnt vmcnt(%0)" :: "i"(n) : "memory")
#define SLOAD_H(Kp, Vp, k0) do { S.st_v0 = load8(ROW(Vp, k0, sr)); S.st_v1 = load8(ROW(Vp, k0, 32 + sr));              \
                         S.st_k0 = load8(ROW(Kp, k0, sr)); S.st_k1 = load8(ROW(Kp, k0, 32 + sr)); } while (0)
#define SWRITE_HK(bf) do { *(bf16x8*)(K_lds + (bf) * SHM_K + kws) = S.st_k0; *(bf16x8*)(K_lds + (bf) * SHM_K + kws + 32 * 256) = S.st_k1; } while (0)
#define SWRITE_HV(bf) do { *(bf16x8*)(V_lds + (bf) * SHM_V + vst0) = S.st_v0; *(bf16x8*)(V_lds + (bf) * SHM_V + vst1) = S.st_v1; } while (0)
#define SWRITE_H(bf) do { SWRITE_HV(bf); SWRITE_HK(bf); } while (0)
__device__ __forceinline__ void block_prime(const BlockRef& cur, char* lds, Seam& S) {
    int tid_l = threadIdx.x; asm volatile("" : "+v"(tid_l)); const int tid = tid_l, wid = __builtin_amdgcn_readfirstlane(tid >> 6), lane = tid & 63, r32 = lane & 31, hi = lane >> 5;
    const int sr = tid >> 4, sc = (tid & 15) * 8, kws = KSWZ(sr, sc * 2); char* K_lds = lds + 2 * SHM_V;
    for (int d0 = 0; d0 < 8; ++d0) S.qr[d0] = load8(cur.Q + (size_t)(wid * QBLK + r32) * D + d0 * 16 + hi * 8);
    SLOAD_H(cur.K, cur.V, cur.jlo * KVBLK); VMW(); SWRITE_HK(0);
    __syncthreads();
}
__device__ __forceinline__ void block_run(const BlockRef& cur, const BlockRef& nxt, char* lds, Seam& S) {
    int tid_l = threadIdx.x; asm volatile("" : "+v"(tid_l)); const int tid = tid_l, wid = __builtin_amdgcn_readfirstlane(tid >> 6), lane = tid & 63, r32 = lane & 31, hi = lane >> 5;
    const int jlo = cur.jlo, NT = cur.P0 / KVBLK + QB / KVBLK - jlo;
    const int qlo = cur.P0 + wid * QBLK, qlo_m = qlo | cur.CH, qm = ((qlo + r32) | cur.CH) - 4 * hi;
    char* V_lds = lds; char* K_lds = lds + 2 * SHM_V;
    float* ws = (float*)(lds + OFF_WS) + wid * 64; float* li_l = ws, * al_l = ws + 32;
    float* bl = (float*)(lds + OFF_BIAS);
    { const int nk = cur.P0 + QB;
      for (int i = jlo * KVBLK + tid * 4; i < nk; i += 2048) { f32x4 v = {0.f, 0.f, 0.f, 0.f}; if (cur.kb) v = *(const f32x4*)(cur.kb + i); *(f32x4*)(bl + i) = v; }
      __syncthreads(); }
    const float* blh = bl + hi * 4;
    float m_reg = -1e30f, l_reg = 0; f32x16 o[4] = {};
    const int sr = tid >> 4, sc = (tid & 15) * 8, vst0 = v_st(sr, sc), vst1 = v_st(32 + sr, sc), kws = KSWZ(sr, sc * 2);
    const int vb0 = (int)(uintptr_t)V_lds + v_rd_base(lane);
    const bf16* Kh = cur.K; const bf16* Vh = cur.V;
#define RESC(a) do { if (__any((a) < 1.f)) { if (hi == 0) al_l[r32] = (a); asm volatile("s_waitcnt lgkmcnt(0)" ::: "memory");              \
                     for (int d_ = 0; d_ < 4; ++d_) for (int r = 0; r < 16; ++r) o[d_][r] *= al_l[crow(r, hi)]; } } while (0)
#define KBASE(t) ((jlo + (t)) * KVBLK)
#define MASKT(P0_, P1_, t) do { const int kb_ = KBASE(t); if (kb_ + KVBLK - 1 > qlo_m) mask_tile(P0_, P1_, qm - kb_, WINF); } while (0)
#define SEAM_K0() do { VMWN(8); SWRITE_HK(0); SBAR(); } while (0)
    f32x16 pA0, pA1, pB0, pB1; float mnA, mnB, alA, alB; bf16x8 pa0, pa1, pa2, pa3;
    SWRITE_HV(0); SBAR();
    if (NT > 1) SLOAD_H(Kh, Vh, KBASE(1));
    SBAR(); qkt<0>(pA0, pA1, K_lds, r32, hi, S.qr, blh + KBASE(0));
    MASKT(pA0, pA1, 0); partialSM(pA0, pA1, m_reg, mnA, alA);
    if (NT > 1) { VMW(); SWRITE_H(1); }
    __syncthreads();
#define HALF_STEP(PX0, PX1, mnX, alX, PY0, PY1, alY, t, KB, VB, SB) do {                                                      \
        SBAR(); qkt<KB>(PX0, PX1, K_lds, r32, hi, S.qr, blh + KBASE(t));                                                      \
        finishSM(PY0, PY1, alY, l_reg, pa0, pa1, pa2, pa3); SBAR();                                                           \
        if ((t) + 1 < NT) { SLOAD_H(Kh, Vh, KBASE((t) + 1)); SBAR(); }                                                        \
        pv_tile<VB>(o, vb0, pa0, pa1, pa2, pa3); MASKT(PX0, PX1, (t)); partialSM(PX0, PX1, m_reg, mnX, alX);                  \
        __syncthreads();                                                                                                      \
        if ((t) + 1 < NT) { VMW(); SWRITE_H(SB); }                                                                            \
        RESC(alX); __syncthreads(); } while (0)
    for (int t = 1; t + 1 < NT; t += 2) {
        HALF_STEP(pB0, pB1, mnB, alB, pA0, pA1, alA, t, 1, 0, 0);
        HALF_STEP(pA0, pA1, mnA, alA, pB0, pB1, alB, t + 1, 0, 1, 1);
    }
    const bool even = (NT & 1) == 0;
    if (even) { SBAR(); qkt<1>(pB0, pB1, K_lds, r32, hi, S.qr, blh + KBASE(NT - 1)); SBAR(); }
    SLOAD_H(nxt.K, nxt.V, nxt.jlo * KVBLK); SBAR();
#pragma unroll
    for (int d0 = 0; d0 < 8; ++d0) S.qr[d0] = load8(nxt.Q + (size_t)(wid * QBLK + r32) * D + d0 * 16 + hi * 8);
    SBAR();
    finishSM(pA0, pA1, alA, l_reg, pa0, pa1, pa2, pa3); SBAR();
    pv_tile<0>(o, vb0, pa0, pa1, pa2, pa3);
    if (even) { MASKT(pB0, pB1, NT - 1); partialSM(pB0, pB1, m_reg, mnB, alB); __syncthreads(); RESC(alB);
        finishSM(pB0, pB1, alB, l_reg, pa0, pa1, pa2, pa3); SBAR(); pv_tile<1>(o, vb0, pa0, pa1, pa2, pa3); }
    SBAR(); SEAM_K0();
    if (hi == 0) li_l[r32] = l_reg; asm volatile("s_waitcnt lgkmcnt(0)" ::: "memory");
    float rli[16];
#pragma unroll
    for (int r = 0; r < 16; ++r) rli[r] = __builtin_amdgcn_rcpf(li_l[crow(r, hi)]);
    bf16* Ow = cur.O + (size_t)(wid * QBLK) * cur.opitch;
#pragma unroll
    for (int r = 0; r < 16; ++r) { const int orow = crow(r, hi);
#pragma unroll
        for (int d0 = 0; d0 < 4; ++d0) { const float v = o[d0][r] * rli[r];
            const float vn = __shfl_xor(v, 1);
            if ((r32 & 1) == 0) *(unsigned*)(Ow + (size_t)orow * cur.opitch + d0 * 32 + r32) = cvtpk(v, vn); } }
    __syncthreads();
#undef RESC
#undef KBASE
#undef MASKT
#undef SEAM_K0
#undef HALF_STEP
}
#undef ROW
#undef VMW
#undef VMWN
#undef SLOAD_H
#undef SWRITE_HK
#undef SWRITE_HV
#undef SWRITE_H
#undef KSWZ
#undef SBAR
}
namespace att2 {
using namespace att;
constexpr int ROWS = 128, SHM_K2 = 16384, SHM_V2 = 32768, SHM_P2 = 16384;
constexpr int OFF_K = 0, OFF_V = 2 * SHM_K2, OFF_P = OFF_V + 2 * SHM_V2, RING_USED = OFF_P + 2 * SHM_P2;
static_assert(RING_USED <= 131072, "att2 LDS");
#define KSWZ2(row, colB) ((row) * 256 + ((colB) ^ (((row) & 7) << 4)))
#define SBAR2() __builtin_amdgcn_sched_barrier(0)
template <int KB>
__device__ __forceinline__ void qkt0(f32x16& p0, f32x16& p1, const char* K_lds, int r32, int hi, const bf16x8* qr) {
    p0 = f32x16{}; p1 = f32x16{};
    const char* kb[4];
#pragma unroll
    for (int dd = 0; dd < 4; ++dd) kb[dd] = K_lds + KB * SHM_K2 + KSWZ2(r32, (dd * 16 + hi * 8) * 2);
#pragma unroll
    for (int d0 = 0; d0 < 8; ++d0) { const char* a = kb[d0 & 3] + (d0 >> 2) * 128;
        bf16x8 b0 = *reinterpret_cast<const bf16x8*>(a);
        bf16x8 b1 = *reinterpret_cast<const bf16x8*>(a + 32 * 256);
        p0 = __builtin_amdgcn_mfma_f32_32x32x16_bf16(b0, qr[d0], p0, 0, 0, 0);
        p1 = __builtin_amdgcn_mfma_f32_32x32x16_bf16(b1, qr[d0], p1, 0, 0, 0); }
}
template <int VB>
__device__ __forceinline__ void pv2(f32x16* o, int vb0, bf16x8 pa0, bf16x8 pa1, bf16x8 pa2, bf16x8 pa3) {
#define TRRD2(dst, off) asm volatile("ds_read_b64_tr_b16 %0, %1 offset:%2" : "=&v"(dst) : "v"(vb0), "i"(off) : "memory")
#define PV2_D0(hv, d0) do { s16x4 l0, l1, l2, l3, h0, h1, h2, h3; constexpr int b_ = VB * SHM_V2 + (hv) * 16384 + v_rd_off(d0, 0, 0);   \
        TRRD2(l0, b_); TRRD2(h0, b_ + 2048); TRRD2(l1, b_ + 4096); TRRD2(h1, b_ + 6144); TRRD2(l2, b_ + 8192); TRRD2(h2, b_ + 10240); TRRD2(l3, b_ + 12288); TRRD2(h3, b_ + 14336); \
        asm volatile("s_waitcnt lgkmcnt(0)" ::: "memory"); SBAR2();   \
        o[(hv) * 4 + (d0)] = __builtin_amdgcn_mfma_f32_32x32x16_bf16(pa0, (bf16x8){l0[0], l0[1], l0[2], l0[3], h0[0], h0[1], h0[2], h0[3]}, o[(hv) * 4 + (d0)], 0, 0, 0);   \
        o[(hv) * 4 + (d0)] = __builtin_amdgcn_mfma_f32_32x32x16_bf16(pa1, (bf16x8){l1[0], l1[1], l1[2], l1[3], h1[0], h1[1], h1[2], h1[3]}, o[(hv) * 4 + (d0)], 0, 0, 0);   \
        o[(hv) * 4 + (d0)] = __builtin_amdgcn_mfma_f32_32x32x16_bf16(pa2, (bf16x8){l2[0], l2[1], l2[2], l2[3], h2[0], h2[1], h2[2], h2[3]}, o[(hv) * 4 + (d0)], 0, 0, 0);   \
        o[(hv) * 4 + (d0)] = __builtin_amdgcn_mfma_f32_32x32x16_bf16(pa3, (bf16x8){l3[0], l3[1], l3[2], l3[3], h3[0], h3[1], h3[2], h3[3]}, o[(hv) * 4 + (d0)], 0, 0, 0); } while (0)
    PV2_D0(0, 0); PV2_D0(0, 1); PV2_D0(0, 2); PV2_D0(0, 3); PV2_D0(1, 0); PV2_D0(1, 1); PV2_D0(1, 2); PV2_D0(1, 3);
#undef PV2_D0
#undef TRRD2
}
struct DRef { const bf16* Q; const bf16* K; const bf16* V0; const bf16* V1; bf16* O; int P0, opitch; const bf16* O1; bf16* Y; const float* lamp; const float* subln; int desc; };
__device__ __forceinline__ void diff_block(const DRef& R, char* lds, PG8_LAS unsigned char* ldsL, float* xl) {
    int tid_l = threadIdx.x; asm volatile("" : "+v"(tid_l)); const int tid = tid_l, wid = __builtin_amdgcn_readfirstlane(tid >> 6), lane = tid & 63, r32 = lane & 31, hi = lane >> 5;
    const bool prod = wid < 4; const int pw = wid & 3;
    const int NT = R.P0 / KVBLK + ROWS / KVBLK;
    const int tix0 = R.desc ? NT - 1 : 0, tixd = R.desc ? -1 : 1;
#define TIX(t) (tix0 + tixd * (t))
    char* K_lds = lds + OFF_K; char* V_lds = lds + OFF_V; char* P_lds = lds + OFF_P;
    float* AL = xl; float* LL = xl + 256; float* AF = xl + 384;
    const int vb0 = (int)(uintptr_t)V_lds + v_rd_base(lane);
    unsigned kgo[2], vgo[4];
#pragma unroll
    for (int i = 0; i < 2; ++i) { const int row = wid * 8 + i * 4 + (lane >> 4); kgo[i] = (unsigned)(row * D + (((lane & 15) ^ (row & 7)) * 8)) * 2u; }
#pragma unroll
    for (int i = 0; i < 4; ++i) { const int blk = ((wid & 3) * 4 + i) * 2 + (lane >> 5), kk = ((blk >> 2) << 3) | ((lane & 31) >> 2), k = (kk & ~0xC) | ((kk & 4) << 1) | ((kk & 8) >> 1);
        vgo[i] = (unsigned)(k * D + (blk & 3) * 32 + (lane & 3) * 8) * 2u; }
    const bf16* Vh; { const unsigned long long v_ = (unsigned long long)(uintptr_t)(wid < 4 ? R.V0 : R.V1);
      Vh = (const bf16*)(uintptr_t)(((unsigned long long)(unsigned)__builtin_amdgcn_readfirstlane((int)(v_ >> 32)) << 32) | (unsigned)__builtin_amdgcn_readfirstlane((int)v_)); }
#define DMA_K(t, buf) do { const char* g_ = (const char*)(R.K + (size_t)TIX(t) * KVBLK * D); _Pragma("unroll") for (int i_ = 0; i_ < 2; ++i_)                                             \
        __builtin_amdgcn_global_load_lds((const unsigned*)(g_ + kgo[i_]), (PG8_LAS unsigned*)(ldsL + OFF_K + (buf) * SHM_K2 + (wid * 2 + i_) * 1024), 16, 0, 0); } while (0)
#define DMA_V(t, buf) do { const char* g_ = (const char*)(Vh + (size_t)TIX(t) * KVBLK * D); _Pragma("unroll") for (int i_ = 0; i_ < 4; ++i_)                                               \
        __builtin_amdgcn_global_load_lds((const unsigned*)(g_ + vgo[i_]), (PG8_LAS unsigned*)(ldsL + OFF_V + (buf) * SHM_V2 + (wid >> 2) * 16384 + ((wid & 3) * 4 + i_) * 1024), 16, 0, 0); } while (0)
#define STAGE(t, PB) do { if ((t) + 1 < NT) DMA_K((t) + 1, 1 - (PB)); DMA_V(t, PB); SBAR2(); } while (0)
#define DMA_PIECE(i, t, PB) do { if ((i) < 2) { if ((t) + 1 < NT) { const char* g_ = (const char*)(R.K + (size_t)TIX((t) + 1) * KVBLK * D);                                                   \
            __builtin_amdgcn_global_load_lds((const unsigned*)(g_ + kgo[(i) & 1]), (PG8_LAS unsigned*)(ldsL + OFF_K + (1 - (PB)) * SHM_K2 + (wid * 2 + ((i) & 1)) * 1024), 16, 0, 0); } }         \
        else { const char* g_ = (const char*)(Vh + (size_t)TIX(t) * KVBLK * D);                                                                                                                  \
            __builtin_amdgcn_global_load_lds((const unsigned*)(g_ + vgo[((i) - 2) & 3]), (PG8_LAS unsigned*)(ldsL + OFF_V + (PB) * SHM_V2 + (wid >> 2) * 16384 + ((wid & 3) * 4 + (((i) - 2) & 3)) * 1024), 16, 0, 0); } } while (0)
#define ENDSTEP() do { asm volatile("s_waitcnt vmcnt(0)" ::: "memory"); __syncthreads(); } while (0)
    if (prod) {
        bf16x8 qr[8]; float m_reg = -1e30f, l_reg = 0.f;
        const int qlo = R.P0 + pw * QBLK, qlo_m = qlo | 63, qm = ((qlo + r32) | 63) - 4 * hi;
        DMA_K(0, 0);
#pragma unroll
        for (int d0 = 0; d0 < 8; ++d0) qr[d0] = load8(R.Q + (size_t)(pw * QBLK + r32) * D + d0 * 16 + hi * 8);
        ENDSTEP();
        const char* kq0 = K_lds + KSWZ2(r32, (0 * 16 + hi * 8) * 2); const char* kq1 = K_lds + KSWZ2(r32, (1 * 16 + hi * 8) * 2);
        const char* kq2 = K_lds + KSWZ2(r32, (2 * 16 + hi * 8) * 2); const char* kq3 = K_lds + KSWZ2(r32, (3 * 16 + hi * 8) * 2);
#define QK_D0(KB, d0) do { const char* a_ = (((d0) & 3) == 0 ? kq0 : ((d0) & 3) == 1 ? kq1 : ((d0) & 3) == 2 ? kq2 : kq3) + (KB) * SHM_K2 + ((d0) >> 2) * 128;   \
            const bf16x8 b0_ = *reinterpret_cast<const bf16x8*>(a_), b1_ = *reinterpret_cast<const bf16x8*>(a_ + 32 * 256);                                    \
            p0 = __builtin_amdgcn_mfma_f32_32x32x16_bf16(b0_, qr[d0], p0, 0, 0, 0); p1 = __builtin_amdgcn_mfma_f32_32x32x16_bf16(b1_, qr[d0], p1, 0, 0, 0); } while (0)
#define PROD_STEP(t, PB) do { f32x16 p0, p1; float mn, al; bf16x8 pa0, pa1, pa2, pa3;                                             \
            p0 = f32x16{}; p1 = f32x16{};                                                                                          \
            QK_D0(PB, 0); QK_D0(PB, 1); DMA_PIECE(0, t, PB); QK_D0(PB, 2); DMA_PIECE(1, t, PB); QK_D0(PB, 3); DMA_PIECE(2, t, PB); QK_D0(PB, 4); DMA_PIECE(3, t, PB); \
            QK_D0(PB, 5); DMA_PIECE(4, t, PB); QK_D0(PB, 6); DMA_PIECE(5, t, PB); QK_D0(PB, 7);                                    \
            { const int kb_ = TIX(t) * KVBLK; if (kb_ + KVBLK - 1 > qlo_m) mask_tile(p0, p1, qm - kb_, WINF); }                   \
            partialSM(p0, p1, m_reg, mn, al); finishSM(p0, p1, al, l_reg, pa0, pa1, pa2, pa3);                                    \
            char* pp_ = P_lds + (PB) * SHM_P2 + pw * 4096 + lane * 16;                                                            \
            *(bf16x8*)(pp_) = pa0; *(bf16x8*)(pp_ + 1024) = pa1; *(bf16x8*)(pp_ + 2048) = pa2; *(bf16x8*)(pp_ + 3072) = pa3;       \
            if (hi == 0) AL[(PB) * 128 + pw * 32 + r32] = al;                                                                     \
            { const bool f_ = __any(al < 1.f); if (lane == 0) AF[(PB) * 4 + pw] = f_ ? 1.f : 0.f; } } while (0)
        for (int t = 0; t < NT; t += 2) { PROD_STEP(t, 0); ENDSTEP(); PROD_STEP(t + 1, 1); ENDSTEP(); }
        if (hi == 0) LL[pw * 32 + r32] = l_reg;
        __syncthreads();
        __syncthreads();
        __syncthreads();
#undef PROD_STEP
#undef QK_D0
    } else {
        f32x16 o[8] = {};
        const int vbq = vb0 + (pw >> 1) * 16384 + (pw & 1) * 1024;
        DMA_K(0, 0);
        ENDSTEP();
#define TRRDQ(dst, off) asm volatile("ds_read_b64_tr_b16 %0, %1 offset:%2" : "=&v"(dst) : "v"(vbq), "i"(off) : "memory")
#define CONS_STEP(PBP  , DMAON, t, PB  ) do {                       \
            s16x4 l_[2][4], h_[2][4];                                                                                              \
            _Pragma("unroll") for (int cb = 0; cb < 2; ++cb) { TRRDQ(l_[cb][0], (PBP) * SHM_V2 + cb * 512); TRRDQ(h_[cb][0], (PBP) * SHM_V2 + cb * 512 + 2048);                 \
                TRRDQ(l_[cb][1], (PBP) * SHM_V2 + cb * 512 + 4096); TRRDQ(h_[cb][1], (PBP) * SHM_V2 + cb * 512 + 6144);                                                          \
                TRRDQ(l_[cb][2], (PBP) * SHM_V2 + cb * 512 + 8192); TRRDQ(h_[cb][2], (PBP) * SHM_V2 + cb * 512 + 10240);                                                         \
                TRRDQ(l_[cb][3], (PBP) * SHM_V2 + cb * 512 + 12288); TRRDQ(h_[cb][3], (PBP) * SHM_V2 + cb * 512 + 14336); }                                                      \
            asm volatile("s_waitcnt lgkmcnt(0)" ::: "memory"); SBAR2();                                                            \
            _Pragma("unroll") for (int rb = 0; rb < 4; ++rb) {                                                                      \
                if (__builtin_amdgcn_readfirstlane(__builtin_bit_cast(int, AF[(PBP) * 4 + rb])) != 0) { const float* al_ = AL + (PBP) * 128 + rb * 32;                                      \
                    _Pragma("unroll") for (int r = 0; r < 16; ++r) { const float a_ = al_[crow(r, hi)]; o[2 * rb][r] *= a_; o[2 * rb + 1][r] *= a_; } }   \
                const char* pp_ = P_lds + (PBP) * SHM_P2 + rb * 4096 + lane * 16;                                                   \
                const bf16x8 pa0 = *(const bf16x8*)(pp_), pa1 = *(const bf16x8*)(pp_ + 1024), pa2 = *(const bf16x8*)(pp_ + 2048), pa3 = *(const bf16x8*)(pp_ + 3072); \
                _Pragma("unroll") for (int cb = 0; cb < 2; ++cb) {                                                                  \
                    o[2 * rb + cb] = __builtin_amdgcn_mfma_f32_32x32x16_bf16(pa0, (bf16x8){l_[cb][0][0], l_[cb][0][1], l_[cb][0][2], l_[cb][0][3], h_[cb][0][0], h_[cb][0][1], h_[cb][0][2], h_[cb][0][3]}, o[2 * rb + cb], 0, 0, 0); \
                    o[2 * rb + cb] = __builtin_amdgcn_mfma_f32_32x32x16_bf16(pa1, (bf16x8){l_[cb][1][0], l_[cb][1][1], l_[cb][1][2], l_[cb][1][3], h_[cb][1][0], h_[cb][1][1], h_[cb][1][2], h_[cb][1][3]}, o[2 * rb + cb], 0, 0, 0); \
                    o[2 * rb + cb] = __builtin_amdgcn_mfma_f32_32x32x16_bf16(pa2, (bf16x8){l_[cb][2][0], l_[cb][2][1], l_[cb][2][2], l_[cb][2][3], h_[cb][2][0], h_[cb][2][1], h_[cb][2][2], h_[cb][2][3]}, o[2 * rb + cb], 0, 0, 0); \
                    o[2 * rb + cb] = __builtin_amdgcn_mfma_f32_32x32x16_bf16(pa3, (bf16x8){l_[cb][3][0], l_[cb][3][1], l_[cb][3][2], l_[cb][3][3], h_[cb][3][0], h_[cb][3][1], h_[cb][3][2], h_[cb][3][3]}, o[2 * rb + cb], 0, 0, 0); } \
                if (DMAON) { if (rb == 0) { DMA_PIECE(0, t, PB); DMA_PIECE(1, t, PB); } else if (rb == 1) { DMA_PIECE(2, t, PB); DMA_PIECE(3, t, PB); } else if (rb == 2) DMA_PIECE(4, t, PB); else DMA_PIECE(5, t, PB); } } } while (0)
        STAGE(0, 0); ENDSTEP(); CONS_STEP(0, 1, 1, 1); ENDSTEP();
        for (int t = 2; t < NT; t += 2) { CONS_STEP(1, 1, t, 0); ENDSTEP(); CONS_STEP(0, 1, t + 1, 1); ENDSTEP(); }
        CONS_STEP(1, 0, 0, 0);
        __syncthreads();
        if (R.O1 == nullptr) {
#pragma unroll
            for (int rb = 0; rb < 4; ++rb)
#pragma unroll
                for (int r = 0; r < 16; ++r) { const int orow = rb * 32 + crow(r, hi); const float rl = __builtin_amdgcn_rcpf(LL[orow]);
#pragma unroll
                    for (int cb = 0; cb < 2; ++cb) { const float v = o[2 * rb + cb][r] * rl; const float vn = __shfl_xor(v, 1);
                        if ((r32 & 1) == 0) *(unsigned*)(R.O + (size_t)orow * R.opitch + 64 * pw + cb * 32 + r32) = cvtpk(v, vn); } }
            __syncthreads();
        } else {
            const bf16* O1w = R.O1 + (size_t)(pw * QBLK) * R.opitch + 4 * lane; bf16* Yw = R.Y + (size_t)(pw * QBLK) * 2048 + 4 * lane;
            unsigned long long a1[32];
#pragma unroll
            for (int rr = 0; rr < 32; ++rr) a1[rr] = *(const unsigned long long*)(O1w + (size_t)rr * R.opitch);
            float* park = (float*)lds;
#pragma unroll
            for (int rb = 0; rb < 4; ++rb)
#pragma unroll
                for (int r = 0; r < 16; ++r) { const int orow = rb * 32 + crow(r, hi); const float rl = __builtin_amdgcn_rcpf(LL[orow]);
#pragma unroll
                    for (int cb = 0; cb < 2; ++cb) park[orow * 256 + 64 * pw + cb * 32 + r32] = o[2 * rb + cb][r] * rl; }
            __syncthreads();
            float s1 = R.lamp[lane] * R.lamp[128 + lane] + R.lamp[64 + lane] * R.lamp[192 + lane], s2 = R.lamp[256 + lane] * R.lamp[384 + lane] + R.lamp[320 + lane] * R.lamp[448 + lane];
#pragma unroll
            for (int of = 1; of < 64; of <<= 1) { s1 += __shfl_xor(s1, of); s2 += __shfl_xor(s2, of); }
            const float lam = __expf(s1) - __expf(s2) + 0.2f;
            const f32x4 gs = *(const f32x4*)(R.subln + 4 * lane) * 0.8f;
            const float* prow = park + (size_t)(pw * QBLK) * 256 + 4 * lane;
#pragma unroll
            for (int rr = 0; rr < 32; ++rr) { const unsigned long long a = a1[rr]; const f32x4 o2 = *(const f32x4*)(prow + rr * 256);
                f32x4 y;
                y.x = __builtin_bit_cast(float, (unsigned)(a << 16)) - lam * o2.x; y.y = __builtin_bit_cast(float, (unsigned)a & 0xffff0000u) - lam * o2.y;
                y.z = __builtin_bit_cast(float, (unsigned)(a >> 32) << 16) - lam * o2.z; y.w = __builtin_bit_cast(float, (unsigned)(a >> 32) & 0xffff0000u) - lam * o2.w;
                float ss = (y.x * y.x + y.y * y.y) + (y.z * y.z + y.w * y.w);
#pragma unroll
                for (int of = 1; of < 64; of <<= 1) ss += __shfl_xor(ss, of);
                const float rs = 1.f / sqrtf(ss * (1.f / 256.f) + 1e-6f);
                y = y * rs * gs;
                *(unsigned long long*)(Yw + (size_t)rr * 2048) = (unsigned long long)cvtpk(y.x, y.y) | ((unsigned long long)cvtpk(y.z, y.w) << 32); } }
        __syncthreads();
#undef CONS_STEP
#undef TRRDQ
    }
#undef STAGE
#undef DMA_PIECE
#undef ENDSTEP
#undef DMA_K
#undef DMA_V
#undef TIX
#undef LD_K
#undef LD_V
#undef ST_K
#undef ST_V
}
#undef KSWZ2
#undef SBAR2
}
#define GAS __attribute__((address_space(1)))
#define LAS __attribute__((address_space(3)))
typedef unsigned short bf16;
typedef unsigned v4u __attribute__((ext_vector_type(4)));
typedef float f32x4 __attribute__((ext_vector_type(4)));
typedef short bf16x8 __attribute__((ext_vector_type(8)));
typedef GAS unsigned gu32;
typedef GAS unsigned long long gu64;
#define RLX_AGENT __ATOMIC_RELAXED, __HIP_MEMORY_SCOPE_AGENT
#define LDS_WAIT() asm volatile("s_waitcnt lgkmcnt(0)" ::: "memory")
#define VM_WAIT() asm volatile("s_waitcnt vmcnt(0)" ::: "memory")
__device__ __forceinline__ unsigned long long rt() { return __builtin_amdgcn_s_memrealtime(); }
__device__ __forceinline__ unsigned f2bf(float f) { unsigned u = __builtin_bit_cast(unsigned, f); return (u + 0x7fffu + ((u >> 16) & 1u)) >> 16; }
__device__ __forceinline__ unsigned pk2(float lo, float hi) { return f2bf(lo) | (f2bf(hi) << 16); }
#define XB_TMO      128
#define XB_XCNT(j)  (256  + 64 * (j))
#define XB_XSUB(j)  (1280 + 64 * (j))
#define XB_XGEN(j)  (2304 + 64 * (j))
#define XB_TOP      3328
#define XB_TOPGEN   3392
#define XCD_BAR_WORDS 3456
#define XB_SPIN_CAP (1u << 18)

__device__ __forceinline__ unsigned xb_ld(unsigned* p)              { return __hip_atomic_load(p, __ATOMIC_RELAXED, __HIP_MEMORY_SCOPE_AGENT); }
__device__ __forceinline__ unsigned xb_add(unsigned* p, unsigned v) { return __hip_atomic_fetch_add(p, v, __ATOMIC_RELAXED, __HIP_MEMORY_SCOPE_AGENT); }
__device__ __forceinline__ unsigned xb_xcc_id() { return (unsigned)__builtin_amdgcn_s_getreg((3 << 11) | 20) & 0xFu; }
#define XB_SPIN(cond, bar) do { unsigned _sp = 0; while (cond) { __builtin_amdgcn_s_sleep(1); \
    if ((++_sp & 255u) == 0u) { if (xb_ld(&(bar)[XB_TMO])) break; if (_sp > XB_SPIN_CAP) { atomicAdd(&(bar)[XB_TMO], 1u); break; } } } } while (0)

struct XcdBarrier {
    unsigned* bar; unsigned x;
    volatile LAS unsigned* st;
};

__device__ __forceinline__ XcdBarrier xcd_barrier_post(unsigned* bar, volatile LAS unsigned* st) {
    XcdBarrier b; b.bar = bar; b.x = xb_xcc_id(); b.st = st;
    if (threadIdx.x == 0) (void)xb_add(&bar[XB_XCNT(b.x)], 1u);
    return b;
}
__device__ __forceinline__ void xcd_barrier_complete(unsigned* bar, unsigned x, unsigned& nloc, unsigned& nx) {
    const unsigned G = gridDim.x * gridDim.y * gridDim.z;
    unsigned sum, cnt, mine, sp = 0u;
    for (;;) {
        sum = 0u; cnt = 0u; mine = 0u;
#pragma unroll
        for (unsigned j = 0; j < 16; ++j) { const unsigned c = xb_ld(&bar[XB_XCNT(j)]); sum += c; cnt += (c > 0u) ? 1u : 0u; mine = (j == x) ? c : mine; }
        if (sum == G) break;
        __builtin_amdgcn_s_sleep(1);
        if ((++sp & 255u) == 0u) { if (xb_ld(&bar[XB_TMO])) break; if (sp > XB_SPIN_CAP) { atomicAdd(&bar[XB_TMO], 1u); break; } }
    }
    nloc = mine > 0u ? mine : 1u; nx = cnt > 0u ? cnt : 1u;
}

__device__ __forceinline__ void xcd_barrier(const XcdBarrier& b) {
    asm volatile("s_waitcnt vmcnt(0)" ::: "memory");
    __syncthreads();
    if (threadIdx.x == 0) {
        unsigned* bar = b.bar;
        __builtin_amdgcn_s_waitcnt(0);
        unsigned nloc = b.st[0], nx = b.st[1];
        if (nloc == 0u) { xcd_barrier_complete(bar, b.x, nloc, nx); b.st[0] = nloc; b.st[1] = nx; }
        const unsigned old = xb_add(&bar[XB_XSUB(b.x)], 1u);
        const unsigned gen = old / nloc;
        if (old + 1u == (gen + 1u) * nloc) {
            __builtin_amdgcn_fence(__ATOMIC_RELEASE, "agent");
            asm volatile("s_waitcnt vmcnt(0)" ::: "memory");
            const unsigned og = xb_add(&bar[XB_TOP], 1u);
            const unsigned tg = og / nx;
            if (og + 1u == (tg + 1u) * nx) xb_add(&bar[XB_TOPGEN], 1u);
            else XB_SPIN(xb_ld(&bar[XB_TOPGEN]) == tg, bar);
            __builtin_amdgcn_fence(__ATOMIC_ACQUIRE, "agent");
            xb_add(&bar[XB_XGEN(b.x)], 1u);
            asm volatile("s_waitcnt vmcnt(0)" ::: "memory");
        } else {
            XB_SPIN(xb_ld(&bar[XB_XGEN(b.x)]) == gen, bar);
            __builtin_amdgcn_fence(__ATOMIC_ACQUIRE, "agent");
            asm volatile("s_waitcnt vmcnt(0)" ::: "memory");
        }
    }
    __syncthreads();
}
__device__ __forceinline__ float wave_sum(float v) {
#pragma unroll
    for (int o = 1; o < 64; o <<= 1) v += __shfl_xor(v, o);
    return v;
}
constexpr int NWAVES = 8;
#ifndef ST_FFN1
#define ST_FFN1 1
#endif
#ifndef ST_MIX
#define ST_MIX 1
#endif
#ifndef ST_FFN2
#define ST_FFN2 1
#endif
#ifndef ST_ATT
#define ST_ATT 1
#endif
#ifndef ST_MA
#define ST_MA 1
#endif
#ifndef ST_P5
#define ST_P5 1
#endif
#ifndef ST_FF
#define ST_FF 1
#endif
constexpr int BATCH = 4, SEQ = 4096, DM = 4096, M = BATCH * SEQ, DFF = 11008, NFF2 = 2 * DFF;
constexpr int INCOLS = 20496, NPROJ = 20480;
constexpr int NADA = 9 * DM, NFADA = 2 * DM, NMODC = NADA + NFADA;
constexpr int KCH = 32, KCHR = DM / KCH;
constexpr float RMS_EPS = 1e-6f;
constexpr size_t MiB = 1u << 20;
constexpr size_t WS_CTL = 0, CTL_ZERO_BYTES = 1 * MiB;
constexpr size_t WS_MODV = 1 * MiB;
constexpr size_t WS_ROPEC = 2 * MiB, WS_ROPES = 3 * MiB;
constexpr size_t WS_KBIAS = 4 * MiB;
constexpr size_t WS_LOGF = 5 * MiB;
constexpr size_t WS_WFF = 6 * MiB;
constexpr size_t WS_PART = 8 * MiB;
constexpr size_t WS_W1IN = 30 * MiB, WS_W1OUT = 202 * MiB, WS_W2IN = 288 * MiB, WS_W2OUT = 460 * MiB, WS_WIN = 546 * MiB, WS_WOFOX = 706 * MiB, WS_WODIFF = 722 * MiB, WS_WOUT = 738 * MiB;
constexpr size_t WS_HB = 770 * MiB;
constexpr size_t WS_BIG = 898 * MiB;
constexpr size_t WS_QKV = WS_BIG, WS_GATES = WS_BIG + 384 * MiB;
constexpr size_t WS_YA = 1538 * MiB;
constexpr size_t WS_ODIFF = 1602 * MiB;
constexpr size_t WS_YB = 1730 * MiB;
constexpr size_t WS_TMP = 1794 * MiB;
constexpr size_t WS_XS = 1922 * MiB;
constexpr size_t WS_END = 2050 * MiB;
static_assert(WS_PART + (size_t)KCH * 4 * NMODC * 4 <= WS_W1IN && WS_W1IN + (size_t)NFF2 * DM * 2 <= WS_W1OUT && WS_W1OUT + (size_t)DM * DFF * 2 <= WS_W2IN && WS_WIN + (size_t)NPROJ * DM * 2 <= WS_WOFOX &&
              WS_BIG + (size_t)M * DFF * 2 <= WS_YA && WS_GATES + (size_t)M * 8192 * 2 <= WS_YA, "d_ws map");
constexpr int CW_BAR = 4096;
constexpr size_t WS_NRM = 768 * 1024;
constexpr int RING_OFF = 0, RING_BYTES = 131072;
constexpr int LDSCTL_OFF = RING_BYTES, MISC_OFF = LDSCTL_OFF + 320;
constexpr int LDS_BYTES = 147456;
constexpr int ATT2_XL_OFF = LDSCTL_OFF + 1024;
static_assert(MISC_OFF + 128 <= LDS_BYTES && att::LDS_BYTES <= RING_BYTES, "LDS map");

template <class Map>
__device__ __forceinline__ void p0_transpose_item(const float* W, int K, int N, const Map& mp, LAS float* scr, int item, int lane) {
    const int nblk = (N + 31) / 32, kb = item / nblk, nb = item % nblk, k0 = 64 * kb, n0 = 32 * nb;
    const bool okc = n0 + (lane & 31) < N;
    float wv[32];
#pragma unroll
    for (int i = 0; i < 32; ++i) { const int kk = 2 * i + (lane >> 5); wv[i] = okc ? W[(size_t)(k0 + kk) * N + n0 + (lane & 31)] : 0.f; }
#pragma unroll
    for (int i = 0; i < 32; ++i) { const int kk = 2 * i + (lane >> 5); scr[kk * 33 + (lane & 31)] = wv[i]; }
    LDS_WAIT(); asm volatile("" ::: "memory");
    const int c = lane & 7;
#pragma unroll
    for (int j = 0; j < 4; ++j) { const int n = (lane >> 3) + 8 * j; const LAS float* s = scr + (8 * c) * 33 + n;
        v4u o; o.x = pk2(s[0 * 33], s[1 * 33]); o.y = pk2(s[2 * 33], s[3 * 33]); o.z = pk2(s[4 * 33], s[5 * 33]); o.w = pk2(s[6 * 33], s[7 * 33]);
        bf16* dst = (n0 + n < N) ? mp(n0 + n) : nullptr;
        if (dst) *(GAS v4u*)(dst + k0 + 8 * c) = o; }
    LDS_WAIT(); asm volatile("" ::: "memory");
}
struct MapId { bf16* WT; int K; __device__ __forceinline__ bf16* operator()(int n) const { return WT + (size_t)n * K; } };
struct MapGlu { bf16* WT; __device__ __forceinline__ bf16* operator()(int n) const { const int up = n >= DFF, j = n - up * DFF; return WT + (size_t)((j >> 7) * 256 + up * 128 + (j & 127)) * DM; } };
struct MapWin { bf16* WT; bf16* WFF; __device__ __forceinline__ bf16* operator()(int n) const {
    if (n >= 6144 && n < 6160) return WFF + (size_t)(n - 6144) * DM;
    int r = n < 6144 ? n : n - 16;
    if (r >= 6144 && r < 10240) { const int a = r & 127; if (a < 32) { const int a2 = a & 15; r = (r & ~127) + 8 * (a2 >> 2) + 4 * (a >> 4) + (a2 & 3); } }
    return WT + (size_t)r * DM; } };

__device__ __forceinline__ void gemv_task(const float* W, int N, const float* cvec, float* part, int ncol_off, int task, LAS float* scs, int lane) {
    const int nstrips = N / 256, kc = task / nstrips, strip = task % nstrips, n = strip * 256 + lane * 4, k0 = kc * KCHR;
#pragma unroll
    for (int j = 0; j < KCHR / 64; ++j) { const int kk = lane + 64 * j;
#pragma unroll
        for (int b = 0; b < 4; ++b) { const float x = cvec[b * DM + k0 + kk]; scs[kk * 4 + b] = x / (1.f + __expf(-x)); } }
    LDS_WAIT(); asm volatile("" ::: "memory");
    f32x4 a0 = {0.f, 0.f, 0.f, 0.f}, a1 = a0, a2 = a0, a3 = a0;
    const float* wp = W + (size_t)k0 * N + n;
#pragma unroll 8
    for (int kk = 0; kk < KCHR; ++kk) { const f32x4 w = *(const GAS f32x4*)(wp + (size_t)kk * N); const f32x4 s4 = *(const LAS f32x4*)(scs + kk * 4);
        a0 += s4[0] * w; a1 += s4[1] * w; a2 += s4[2] * w; a3 += s4[3] * w; }
    float* pp = part + (size_t)(kc * 4) * NMODC + ncol_off + n;
    *(GAS f32x4*)(pp) = a0; *(GAS f32x4*)(pp + NMODC) = a1; *(GAS f32x4*)(pp + 2 * NMODC) = a2; *(GAS f32x4*)(pp + 3 * NMODC) = a3;
    LDS_WAIT(); asm volatile("" ::: "memory");
}
__constant__ float c_inv_freq[16] = {1.000000000e+00f, 4.403665960e-01f, 1.939227432e-01f, 8.539710194e-02f, 3.760603070e-02f, 1.656043902e-02f, 7.292664610e-03f, 3.211445874e-03f,
                                     1.414213562e-03f, 6.227723788e-04f, 2.742481884e-04f, 1.207697351e-04f, 5.318296098e-05f, 2.341999971e-05f, 1.031338616e-05f, 4.541670478e-06f};
__device__ __forceinline__ void sincos_f64(float angf, float& c, float& s) {
    const double a = (double)angf; const double kq = __builtin_rint(a * 0.63661977236758134308);
    const double r = (a - kq * 1.57079632679489655800e+00) - kq * 6.12323399573676603587e-17; const double r2 = r * r;
    const double sp = r * (1.0 + r2 * (-1.66666666666666324348e-01 + r2 * (8.33333333332248946124e-03 + r2 * (-1.98412698298579493134e-04 + r2 * (2.75573137070700676789e-06 + r2 * (-2.50507602534068634195e-08 + r2 * 1.58969099521155010221e-10))))));
    const double cp = 1.0 + r2 * (-0.5 + r2 * (4.16666666666666019037e-02 + r2 * (-1.38888888888741095749e-03 + r2 * (2.48015872894767294178e-05 + r2 * (-2.75573143513906633035e-07 + r2 * (2.08757232129817482790e-09 + r2 * -1.13596475577881948265e-11))))));
    const int q = (int)((long long)kq & 3);
    const double sv = (q & 1) ? cp : sp, cv = (q & 1) ? sp : cp;
    s = (float)((q & 2) ? -sv : sv); c = (float)(((q + 1) & 2) ? -cv : cv);
}

template <bool OUT_F32, bool IN_BF16>
__device__ __forceinline__ void norm_phase(const void* X, void* OUT, const float* Avec, const float* SHvec, LAS unsigned char* lds, int vcu, int G, int tid, int wave, int lane, bool poison) {
    LAS f32x4* LA = (LAS f32x4*)lds; LAS f32x4* LS = (LAS f32x4*)(lds + 16384);
    for (int panel = vcu; panel < M / 64; panel += G) { const int b = panel >> 6;
        for (int i = tid; i < 1024; i += NWAVES * 64) { LA[i] = *(const GAS f32x4*)(Avec + b * DM + 4 * i); LS[i] = *(const GAS f32x4*)(SHvec + b * DM + 4 * i); }
        __syncthreads();
        for (int rr = 0; rr < 8; ++rr) { const int row = panel * 64 + wave * 8 + rr;
            f32x4 v[16]; float ss = 0.f;
            if (IN_BF16) { const GAS v4u* xr = (const GAS v4u*)((const bf16*)X + (size_t)row * DM) + lane;
#pragma unroll
                for (int j = 0; j < 8; ++j) { const v4u w = xr[64 * j];
                    v[2 * j] = (f32x4){__builtin_bit_cast(float, w.x << 16), __builtin_bit_cast(float, w.x & 0xffff0000u), __builtin_bit_cast(float, w.y << 16), __builtin_bit_cast(float, w.y & 0xffff0000u)};
                    v[2 * j + 1] = (f32x4){__builtin_bit_cast(float, w.z << 16), __builtin_bit_cast(float, w.z & 0xffff0000u), __builtin_bit_cast(float, w.w << 16), __builtin_bit_cast(float, w.w & 0xffff0000u)}; } }
            else { const GAS f32x4* xr = (const GAS f32x4*)((const float*)X + (size_t)row * DM) + lane;
#pragma unroll
                for (int j = 0; j < 16; ++j) v[j] = xr[64 * j]; }
#pragma unroll
            for (int j = 0; j < 16; ++j) ss += (v[j].x * v[j].x + v[j].y * v[j].y) + (v[j].z * v[j].z + v[j].w * v[j].w);
            float r = 1.f / sqrtf(wave_sum(ss) * (1.f / DM) + RMS_EPS); if (poison) r = __builtin_nanf("");
#pragma unroll
            for (int j = 0; j < 16; ++j) { const int ci = IN_BF16 ? 2 * (lane + 64 * (j >> 1)) + (j & 1) : lane + 64 * j;
                const f32x4 y = v[j] * r * LA[ci] + LS[ci];
                if (OUT_F32) ((GAS f32x4*)((float*)OUT + (size_t)row * DM))[ci] = y;
                else ((GAS unsigned long long*)((bf16*)OUT + (size_t)row * DM))[ci] = (unsigned long long)pk2(y.x, y.y) | ((unsigned long long)pk2(y.z, y.w) << 32); } }
        __syncthreads(); }
}

__device__ __forceinline__ void ff_phase(const bf16* H, const bf16* Wff, const float* bfg, float* logf, int vcu, int G, int wave, int lane) {
    const int fr = lane & 15, fq = lane >> 4;
    for (int t = wave * G + vcu; t < M / 16; t += NWAVES * G) { const int row0 = t * 16; f32x4 acc = {0.f, 0.f, 0.f, 0.f};
        const bf16* ap = H + (size_t)(row0 + fr) * DM + 8 * fq; const bf16* wp = Wff + (size_t)fr * DM + 8 * fq;
#pragma unroll 8
        for (int ks = 0; ks < DM / 32; ++ks) { const bf16x8 a = *(const GAS bf16x8*)(ap + 32 * ks), w = *(const GAS bf16x8*)(wp + 32 * ks); acc = __builtin_amdgcn_mfma_f32_16x16x32_bf16(w, a, acc, 0, 0, 0); }
        const int b = row0 >> 12, s = (row0 & 4095) + fr;
#pragma unroll
        for (int j = 0; j < 4; ++j) { const int h = 4 * fq + j; const float z = acc[j] + bfg[h]; const float ls = fminf(z, 0.f) - log1pf(__expf(-fabsf(z))); logf[(size_t)(b * 16 + h) * SEQ + s] = ls; } }
}
__device__ __forceinline__ void cumsum_phase(const float* logf, float* kbias, LAS unsigned char* lds, int vcu, int G, int tid, int wave, int lane) {
    LAS float* wt = (LAS float*)lds;
    for (int bh = vcu; bh < 64; bh += G) {
        const f32x4 x0 = *(const GAS f32x4*)(logf + (size_t)bh * SEQ + tid * 8), x1 = *(const GAS f32x4*)(logf + (size_t)bh * SEQ + tid * 8 + 4);
        float p[8]; p[0] = x0.x; p[1] = p[0] + x0.y; p[2] = p[1] + x0.z; p[3] = p[2] + x0.w; p[4] = p[3] + x1.x; p[5] = p[4] + x1.y; p[6] = p[5] + x1.z; p[7] = p[6] + x1.w;
        float sc = p[7];
#pragma unroll
        for (int o = 1; o < 64; o <<= 1) { const float t = __shfl_up(sc, o); if (lane >= o) sc += t; }
        if (lane == 63) wt[wave] = sc;
        __syncthreads();
        float base = sc - p[7];
        for (int w = 0; w < wave; ++w) base += wt[w];
        const float k = -11.313708498984761f;
        f32x4 o0, o1; o0.x = (base + p[0]) * k; o0.y = (base + p[1]) * k; o0.z = (base + p[2]) * k; o0.w = (base + p[3]) * k; o1.x = (base + p[4]) * k; o1.y = (base + p[5]) * k; o1.z = (base + p[6]) * k; o1.w = (base + p[7]) * k;
        *(GAS f32x4*)(kbias + (size_t)bh * SEQ + tid * 8) = o0; *(GAS f32x4*)(kbias + (size_t)bh * SEQ + tid * 8 + 4) = o1;
        __syncthreads(); }
}
__device__ __forceinline__ void qknorm_phase(const bf16* FQ, const bf16* FK, unsigned* nrm, int vcu, int G, int wave, int lane) {
    for (int work = vcu; work < 256; work += G) { const int bh = work >> 2, part = work & 3;
        const bf16* qp = FQ + ((size_t)bh * SEQ + part * 1024) * 128 + (lane >> 4) * 128 + (lane & 15) * 8; const bf16* kp = FK + ((size_t)bh * SEQ + part * 1024) * 128 + (lane >> 4) * 128 + (lane & 15) * 8;
        float mq = 0.f, mk = 0.f;
#pragma unroll 4
        for (int it = wave; it < 256; it += NWAVES) { const v4u a = *(const GAS v4u*)(qp + (size_t)it * 512), c = *(const GAS v4u*)(kp + (size_t)it * 512);
            float sq = 0.f, sk = 0.f;
#pragma unroll
            for (int e = 0; e < 4; ++e) { const float a0 = __builtin_bit_cast(float, a[e] << 16), a1 = __builtin_bit_cast(float, a[e] & 0xffff0000u), c0 = __builtin_bit_cast(float, c[e] << 16), c1 = __builtin_bit_cast(float, c[e] & 0xffff0000u);
                sq += a0 * a0 + a1 * a1; sk += c0 * c0 + c1 * c1; }
#pragma unroll
            for (int o = 1; o < 16; o <<= 1) { sq += __shfl_xor(sq, o); sk += __shfl_xor(sk, o); }
            mq = fmaxf(mq, sq); mk = fmaxf(mk, sk); }
#pragma unroll
        for (int o = 16; o < 64; o <<= 1) { mq = fmaxf(mq, __shfl_xor(mq, o)); mk = fmaxf(mk, __shfl_xor(mk, o)); }
        if (lane == 0) { atomicMax(nrm + bh, __builtin_bit_cast(unsigned, mq)); atomicMax(nrm + 64 + bh, __builtin_bit_cast(unsigned, mk)); } }
}
__device__ __forceinline__ void diffcomb_phase(const bf16* OD, bf16* YB, const float* lamp, const float* subln, int vcu, int G, int wave, int lane) {
    float s1 = lamp[lane] * lamp[128 + lane] + lamp[64 + lane] * lamp[192 + lane], s2 = lamp[256 + lane] * lamp[384 + lane] + lamp[320 + lane] * lamp[448 + lane];
    s1 = wave_sum(s1); s2 = wave_sum(s2);
    const float lam = __expf(s1) - __expf(s2) + 0.2f;
    const f32x4 g = *(const GAS f32x4*)(subln + 4 * lane) * 0.8f;
    const int gw = vcu * NWAVES + wave, NGW = G * NWAVES;
    for (int m = gw; m < M; m += NGW) { const bf16* orow = OD + (size_t)m * 4096; bf16* yrow = YB + (size_t)m * 2048;
#pragma unroll 4
        for (int h = 0; h < 8; ++h) { const unsigned long long a = *(const GAS unsigned long long*)(orow + h * 512 + 4 * lane), c = *(const GAS unsigned long long*)(orow + h * 512 + 256 + 4 * lane);
            f32x4 y;
            y.x = __builtin_bit_cast(float, (unsigned)(a << 16)) - lam * __builtin_bit_cast(float, (unsigned)(c << 16));
            y.y = __builtin_bit_cast(float, (unsigned)a & 0xffff0000u) - lam * __builtin_bit_cast(float, (unsigned)c & 0xffff0000u);
            y.z = __builtin_bit_cast(float, (unsigned)(a >> 32) << 16) - lam * __builtin_bit_cast(float, (unsigned)(c >> 32) << 16);
            y.w = __builtin_bit_cast(float, (unsigned)(a >> 32) & 0xffff0000u) - lam * __builtin_bit_cast(float, (unsigned)(c >> 32) & 0xffff0000u);
            const float r = 1.f / sqrtf(wave_sum((y.x * y.x + y.y * y.y) + (y.z * y.z + y.w * y.w)) * (1.f / 256.f) + RMS_EPS);
            y = y * r * g;
            *(GAS unsigned long long*)(yrow + h * 256 + 4 * lane) = (unsigned long long)pk2(y.x, y.y) | ((unsigned long long)pk2(y.z, y.w) << 32); } }
}

__device__ __forceinline__ att::BlockRef att_ref(unsigned char* ws, int j, int G, int cc) {
    const int Lp = (j >> 1) * G + cc, grp = Lp >> 3, xx = Lp & 7, qb = (j & 1) ? 15 - xx : xx;
    att::BlockRef r;
    const att::bf16* Q6 = (const att::bf16*)(ws + WS_QKV); const size_t TS = (size_t)M * 2048, HS = (size_t)SEQ * 128;
    if (grp < 64) { const int b = grp >> 4, h = grp & 15;
        r.Q = Q6 + (size_t)grp * HS + (size_t)qb * 256 * 128; r.K = Q6 + TS + (size_t)grp * HS; r.V = Q6 + 2 * TS + (size_t)grp * HS;
        r.O = (att::bf16*)(ws + WS_YA) + ((size_t)b * SEQ + qb * 256) * 2048 + h * 128; r.opitch = 2048; r.kb = (const float*)(ws + WS_KBIAS) + (size_t)grp * SEQ; r.CH = 0;
        { const unsigned* nrm = (const unsigned*)(ws + WS_NRM); const float B = sqrtf(__builtin_bit_cast(float, nrm[grp]) * __builtin_bit_cast(float, nrm[64 + grp]));
          const float th = 2.02f * B + 1250.f; const int lane = threadIdx.x & 63, nb = qb * 4;
          const float k0 = r.kb[qb * 256], kv = r.kb[(lane < nb ? lane : 0) * 64 + 63];
          const unsigned long long msk = __ballot(lane < nb && (k0 - kv) > th);
          r.jlo = __builtin_amdgcn_readfirstlane((int)__builtin_ctzll(~msk)); } }
    else { const int vh = grp - 64, b = vh >> 5, rr = vh & 31, h = rr >> 2, n = (rr >> 1) & 1, half = rr & 1;
        r.Q = Q6 + 3 * TS + (size_t)(b * 16 + h * 2 + n) * HS + (size_t)qb * 256 * 128; r.K = Q6 + 4 * TS + (size_t)(b * 16 + h * 2 + n) * HS; r.V = Q6 + 5 * TS + (size_t)(b * 16 + h * 2 + half) * HS;
        r.O = (att::bf16*)(ws + WS_ODIFF) + ((size_t)b * SEQ + qb * 256) * 4096 + h * 512 + n * 256 + half * 128; r.opitch = 4096; r.kb = nullptr; r.CH = 63; r.jlo = 0; }
    r.P0 = qb * 256; return r;
}
#define PH_BEGIN size_t ws_z = 0; asm volatile("" : "+s"(ws_z)); unsigned char* ws = args.ws + ws_z; int tid = threadIdx.x; asm volatile("" : "+v"(tid)); const int lane = tid & 63, wave = __builtin_amdgcn_readfirstlane(tid >> 6); (void)lane; (void)wave; (void)ws;
#define P_F32(off) ((float*)(ws + (off)))
#define P_BF(off) ((bf16*)(ws + (off)))
#define MODV P_F32(WS_MODV)
#define ROPEC P_F32(WS_ROPEC)
#define ROPES P_F32(WS_ROPES)
#define KBIAS P_F32(WS_KBIAS)
#define LOGF P_F32(WS_LOGF)
#define PART P_F32(WS_PART)
#define WFF P_BF(WS_WFF)
#define W1IN P_BF(WS_W1IN)
#define W1OUT P_BF(WS_W1OUT)
#define W2IN P_BF(WS_W2IN)
#define W2OUT P_BF(WS_W2OUT)
#define WIN P_BF(WS_WIN)
#define WOFOX P_BF(WS_WOFOX)
#define WODIFF P_BF(WS_WODIFF)
#define WOUT P_BF(WS_WOUT)
#define HB P_BF(WS_HB)
#define ACT P_BF(WS_BIG)
#define QKV P_BF(WS_QKV)
#define GATES P_BF(WS_GATES)
#define YA P_BF(WS_YA)
#define ODIFF P_BF(WS_ODIFF)
#define YB P_BF(WS_YB)
#define TMP P_BF(WS_TMP)
#define XS P_BF(WS_XS)
#define XIN ((const float*)args.in[0])
#define MV(k) (MODV + (k) * 16384)
struct Args { const void* in[23]; float* out; unsigned char* ws; };
__global__ void __launch_bounds__(NWAVES * 64, 2) mk_fwd(Args args) {
    extern __shared__ __attribute__((aligned(16))) unsigned char lds[];
    LAS unsigned char* L = (LAS unsigned char*)lds;
    volatile LAS unsigned* MISC = (volatile LAS unsigned*)(L + MISC_OFF);
    const int tid0 = threadIdx.x;
    const int G = gridDim.x; int vcu; { const int bx = blockIdx.x; vcu = (G % 8 == 0) ? (bx % 8) * (G / 8) + bx / 8 : bx; }
    gu32* ctl = (gu32*)(args.ws + WS_CTL);
    float* out = args.out;
    for (int u = tid0; u < (LDS_BYTES - LDSCTL_OFF) / 4; u += NWAVES * 64) ((LAS unsigned*)(L + LDSCTL_OFF))[u] = 0u;
    __syncthreads();
    XcdBarrier bar = xcd_barrier_post((unsigned*)(ctl + CW_BAR), MISC + 8);
#define GRID_BAR() xcd_barrier(bar)

    { PH_BEGIN
        const int gw = vcu * NWAVES + wave, NGW = G * NWAVES;
        const float* cvec = (const float*)args.in[1]; const int* pos = (const int*)args.in[2];
        LAS float* scr = (LAS float*)(L + RING_OFF + wave * 16384);
        constexpr int T_ADA = KCH * (NADA / 256), T_FADA = KCH * (NFADA / 256);
        constexpr int I_FIN = (DM / 64) * (NFF2 / 32), I_FOUT = (DFF / 64) * (DM / 32), I_WIN = (DM / 64) * ((INCOLS + 31) / 32), I_WO = (2048 / 64) * (DM / 32), I_WOUT = (DM / 64) * (DM / 32);
        constexpr int NITEMS = T_ADA + T_FADA + 2 * I_FIN + I_FOUT + I_WIN;
        for (int it = gw; it < NITEMS; it += NGW) {
            int r = it;
            if (r < T_ADA) { gemv_task((const float*)args.in[3], NADA, cvec, PART, 0, r, scr, lane); continue; } r -= T_ADA;
            if (r < T_FADA) { gemv_task((const float*)args.in[20], NFADA, cvec, PART, NADA, r, scr, lane); continue; } r -= T_FADA;
            if (r < I_FIN) { p0_transpose_item((const float*)args.in[6], DM, NFF2, MapGlu{W1IN}, scr, r, lane); continue; } r -= I_FIN;
            if (r < I_FOUT) { p0_transpose_item((const float*)args.in[7], DFF, DM, MapId{W1OUT, DFF}, scr, r, lane); continue; } r -= I_FOUT;
            if (r < I_WIN) { p0_transpose_item((const float*)args.in[9], DM, INCOLS, MapWin{WIN, WFF}, scr, r, lane); continue; } r -= I_WIN;
            p0_transpose_item((const float*)args.in[18], DM, NFF2, MapGlu{W2IN}, scr, r, lane);
        }
        for (int i = vcu * NWAVES * 64 + tid; i < M * 16; i += G * NWAVES * 64) { const int m = i >> 4, j = i & 15; float c, s; sincos_f64((float)pos[m] * c_inv_freq[j], c, s); ROPEC[i] = c; ROPES[i] = s; }
    }
    GRID_BAR();
    { PH_BEGIN
      for (int idx = vcu * NWAVES * 64 + tid; idx < 11 * 4 * DM; idx += G * NWAVES * 64) {
        const int q = idx >> 14, r = idx & 16383, b = r >> 12, col = r & 4095;
        const int ncol = q < 9 ? q * DM + col : NADA + (q - 9) * DM + col;
        float s = q < 9 ? ((const float*)args.in[4])[q * DM + col] : ((const float*)args.in[21])[(q - 9) * DM + col];
#pragma unroll 8
        for (int kc = 0; kc < KCH; ++kc) s += PART[(size_t)(kc * 4 + b) * NMODC + ncol];
        float o = s;
        if (q == 1) o = ((const float*)args.in[5])[col] * (1.f + s); else if (q == 4) o = ((const float*)args.in[8])[col] * (1.f + s); else if (q == 7) o = ((const float*)args.in[17])[col] * (1.f + s);
        else if (q == 10) o = ((const float*)args.in[22])[col] * (1.f + s); else if (q == 2 || q == 8) o = 0.5f * s;
        MODV[idx] = o;
      } }
    GRID_BAR();

#if ST_FFN1
    { PH_BEGIN norm_phase<false, false>(XIN, HB, MV(1), MV(0), L + RING_OFF, vcu, G, tid, wave, lane, false); }
    GRID_BAR();
    { PH_BEGIN pg8::Gemm g{HB, W1IN, M, NFF2, DM}; pg8::StaticOrder S; S.init(M, NFF2, G, (int)blockIdx.x); pg8::EpiSwiGLU E{ACT, DFF};
      pg8::gemm_phase<pg8::EpiSwiGLU, pg8::StaticOrder, true, true>(L + RING_OFF, g, S, E); }
    { PH_BEGIN const int nwg = (M / 256) * (NFF2 / 256), rem = nwg % G, c = (int)blockIdx.x;
      if (c >= rem) { const int pw = (c - rem) * NWAVES + wave, PW = (G - rem) * NWAVES; LAS float* scr = (LAS float*)(L + RING_OFF + wave * 16384);
        for (int it = pw; it < (DFF / 64) * (DM / 32); it += PW) p0_transpose_item((const float*)args.in[19], DFF, DM, MapId{W2OUT, DFF}, scr, it, lane);
        for (int it = pw; it < (DM / 64) * (DM / 32); it += PW) p0_transpose_item((const float*)args.in[16], DM, DM, MapId{WOUT, DM}, scr, it, lane);
        for (int it = pw; it < (2048 / 64) * (DM / 32); it += PW) { p0_transpose_item((const float*)args.in[14], 2048, DM, MapId{WOFOX, 2048}, scr, it, lane); p0_transpose_item((const float*)args.in[15], 2048, DM, MapId{WODIFF, 2048}, scr, it, lane); } } }
    GRID_BAR();
    { PH_BEGIN pg8::Gemm g{ACT, W1OUT, M, DM, DFF, 0, 1}; pg8::StaticOrder S; S.init(M, DM, G, (int)blockIdx.x); pg8::EpiResidB<true> E{XIN, XS, MV(2)};
      pg8::gemm_phase<pg8::EpiResidB<true>, pg8::StaticOrder, true, true>(L + RING_OFF, g, S, E); }
    GRID_BAR();
#else
    { PH_BEGIN for (size_t i = (size_t)(vcu * NWAVES * 64 + tid); i < (size_t)M * DM / 4; i += (size_t)G * NWAVES * 64) ((GAS f32x4*)out)[i] = ((const GAS f32x4*)XIN)[i]; }
    GRID_BAR();
#endif

#if ST_MIX
    { PH_BEGIN norm_phase<false, true>(XS, HB, MV(4), MV(3), L + RING_OFF, vcu, G, tid, wave, lane, false); }
    GRID_BAR();
#if !ST_P5
    { PH_BEGIN for (size_t i = (size_t)(vcu * NWAVES * 64 + tid); i < (size_t)M * 8192 * 2 / 16; i += (size_t)G * NWAVES * 64) ((GAS v4u*)GATES)[i] = (v4u){0x3f003f00u, 0x3f003f00u, 0x3f003f00u, 0x3f003f00u}; }
    GRID_BAR();
    GRID_BAR();
#else
    { PH_BEGIN pg8::Gemm g{HB, WIN, M, NPROJ, DM}; pg8::StaticOrder S; S.init(M, NPROJ, G, (int)blockIdx.x); pg8::EpiProj E{QKV, GATES, (const float*)args.in[11], ROPEC, ROPES};
      pg8::gemm_phase<pg8::EpiProj, pg8::StaticOrder, true, true>(L + RING_OFF, g, S, E); }
#if ST_FF
    { PH_BEGIN ff_phase(HB, WFF, (const float*)args.in[10], LOGF, vcu, G, wave, lane); }
#endif
    GRID_BAR();
#if ST_FF
    { PH_BEGIN qknorm_phase(QKV, QKV + (size_t)M * 2048, (unsigned*)(ws + WS_NRM), vcu, G, wave, lane);
      cumsum_phase(LOGF, KBIAS, L + RING_OFF, vcu, G, tid, wave, lane); }
#endif
    GRID_BAR();
#endif
#if !ST_ATT
    { PH_BEGIN for (size_t i = (size_t)(vcu * NWAVES * 64 + tid); i < (size_t)M * 2048 * 2 / 16; i += (size_t)G * NWAVES * 64) ((GAS v4u*)YA)[i] = (v4u){0u, 0u, 0u, 0u};
      for (size_t i = (size_t)(vcu * NWAVES * 64 + tid); i < (size_t)M * 4096 * 2 / 16; i += (size_t)G * NWAVES * 64) ((GAS v4u*)ODIFF)[i] = (v4u){0x3f803f80u, 0x3f803f80u, 0x3f803f80u, 0x3f803f80u}; }
#else
    { PH_BEGIN
        const int cc = (G % 8 == 0) ? ((int)blockIdx.x % 8) * (G / 8) + (int)blockIdx.x / 8 : (int)blockIdx.x;
        { constexpr int TOTAL = 64 * 8;
          const int nit = cc < TOTAL ? (TOTAL - 1 - cc) / G + 1 : 0;
          if (nit > 0) {
            att::Seam SM; att::BlockRef cur = att_ref(ws, 0, G, cc);
            att::block_prime(cur, (char*)lds + RING_OFF, SM);
            for (int j = 0; j < 2 * nit; ++j) { const att::BlockRef nxt = (j + 1 < 2 * nit) ? att_ref(ws, j + 1, G, cc) : cur;
                att::block_run(cur, nxt, (char*)lds + RING_OFF, SM); cur = nxt; } } }
        { constexpr int TOTAL2 = 32 * 16;
          for (int Lp = cc; Lp < TOTAL2; Lp += G) { const int g2 = Lp >> 4, xx = Lp & 15, b = g2 >> 3, h = g2 & 7;
            const att::bf16* Q6 = (const att::bf16*)(ws + WS_QKV); const size_t TS = (size_t)M * 2048, HS = (size_t)SEQ * 128;
            for (int pass = 0; pass < 4; ++pass) { const int qb = (pass & 1) ? xx : 31 - xx, n = pass >> 1;
                att2::DRef r; r.Q = Q6 + 3 * TS + (size_t)(b * 16 + h * 2 + n) * HS + (size_t)qb * 128 * 128; r.K = Q6 + 4 * TS + (size_t)(b * 16 + h * 2 + n) * HS;
                r.V0 = Q6 + 5 * TS + (size_t)(b * 16 + h * 2) * HS; r.V1 = r.V0 + HS;
                att::bf16* o1p = (att::bf16*)(ws + WS_ODIFF) + ((size_t)b * SEQ + qb * 128) * 4096 + h * 512;
                r.O = o1p; r.opitch = 4096; r.P0 = qb * 128; r.O1 = n ? o1p : nullptr;
                r.Y = (att::bf16*)(ws + WS_YB) + ((size_t)b * SEQ + qb * 128) * 2048 + h * 256; r.lamp = (const float*)args.in[12]; r.subln = (const float*)args.in[13]; r.desc = pass & 1;
                att2::diff_block(r, (char*)lds + RING_OFF, L + RING_OFF, (float*)((char*)lds + ATT2_XL_OFF)); } } }
    }
#endif
    GRID_BAR();
#if !ST_MA
    { PH_BEGIN for (size_t i = (size_t)(vcu * NWAVES * 64 + tid); i < (size_t)M * 4096 * 2 / 16; i += (size_t)G * NWAVES * 64) ((GAS v4u*)TMP)[i] = (v4u){0u, 0u, 0u, 0u}; }
    GRID_BAR();
#else
    { PH_BEGIN pg8::Gemm g{YA, WOFOX, M, DM, 2048}; pg8::StaticOrder S; S.init(M, DM, G, (int)blockIdx.x); pg8::EpiMerge<true> E{GATES, 0, nullptr, TMP};
      pg8::gemm_phase<pg8::EpiMerge<true>, pg8::StaticOrder, true, true>(L + RING_OFF, g, S, E); }
#endif
    { PH_BEGIN pg8::Gemm g{YB, WODIFF, M, DM, 2048}; pg8::StaticOrder S; S.init(M, DM, G, (int)blockIdx.x); pg8::EpiMerge<false> E{GATES, 4096, TMP, HB};
      pg8::gemm_phase<pg8::EpiMerge<false>, pg8::StaticOrder, true, true>(L + RING_OFF, g, S, E); }
    GRID_BAR();
    { PH_BEGIN pg8::Gemm g{HB, WOUT, M, DM, DM}; pg8::StaticOrder S; S.init(M, DM, G, (int)blockIdx.x); pg8::EpiResidB<false> E{XS, XS, MV(5)};
      pg8::gemm_phase<pg8::EpiResidB<false>, pg8::StaticOrder, true, true>(L + RING_OFF, g, S, E); }
    GRID_BAR();
#endif

#if ST_FFN2
    { PH_BEGIN norm_phase<false, true>(XS, HB, MV(7), MV(6), L + RING_OFF, vcu, G, tid, wave, lane, false); }
    GRID_BAR();
    { PH_BEGIN constexpr int NWG = (M / 256) * (NFF2 / 256);
      const bool split = (G % 2 == 0) && (NWG % G == G / 2);
      { pg8::Gemm g{HB, W2IN, M, NFF2, DM}; pg8::LimitedOrder S; S.init(M, NFF2, G, (int)blockIdx.x); S.maxi = split ? NWG / G : (NWG + G - 1) / G; pg8::EpiSwiGLU E{ACT, DFF};
        pg8::gemm_phase<pg8::EpiSwiGLU, pg8::LimitedOrder, true, true>(L + RING_OFF, g, S, E); }
      if (split) { const int c = (int)blockIdx.x, hc = G / 2, cu = c % hc; const bool helper = c >= hc;
        float* slab = P_F32(WS_TMP) + (size_t)cu * 65536; unsigned* flag = (unsigned*)(args.ws + WS_NRM + 4096) + 64 * cu;
        pg8::Gemm g{HB + (helper ? DM / 2 : 0), W2IN + (helper ? DM / 2 : 0), M, NFF2, DM / 2, DM};
        pg8::OneUnitOrder S; S.init(M, NFF2, G, c); S.round = NWG / G; S.cu = cu;
        if (helper) { pg8::EpiSlabStore E{slab, flag}; pg8::gemm_phase<pg8::EpiSlabStore, pg8::OneUnitOrder, true, true>(L + RING_OFF, g, S, E); }
        else { pg8::EpiSlabSwiGLU E{ACT, DFF, slab, flag, (unsigned*)(ctl + CW_BAR + XB_TMO)}; pg8::gemm_phase<pg8::EpiSlabSwiGLU, pg8::OneUnitOrder, true, true>(L + RING_OFF, g, S, E); } } }
    GRID_BAR();
    { PH_BEGIN pg8::Gemm g{ACT, W2OUT, M, DM, DFF, 0, 1}; pg8::StaticOrder S; S.init(M, DM, G, (int)blockIdx.x); pg8::EpiResidB<false> E{XS, XS, MV(8)};
      pg8::gemm_phase<pg8::EpiResidB<false>, pg8::StaticOrder, true, true>(L + RING_OFF, g, S, E); }
    GRID_BAR();
#endif
    { PH_BEGIN const bool poison = __hip_atomic_load((gu32*)(ctl + CW_BAR + XB_TMO), RLX_AGENT) != 0u;
      norm_phase<true, true>(XS, out, MV(10), MV(9), L + RING_OFF, vcu, G, tid, wave, lane, poison); }
}

extern "C" void kernel_launch(void* const* d_in, const int* in_sizes, int n_in, void* d_out, int out_size, void* d_ws, size_t ws_size, hipStream_t stream) {
    static int grid = 0;
    if (grid == 0) {
        if (n_in != 23 || in_sizes[0] != M * DM || out_size != M * DM || ws_size < WS_END) { fprintf(stderr, "kernel_launch: unexpected shapes (n_in %d, in0 %d, out %d, ws %zu < %zu); nothing launched\n", n_in, n_in > 0 ? in_sizes[0] : -1, out_size, ws_size, (size_t)WS_END); grid = -1; return; }
        int dev = 0, cus = 0, per_cu = 0;
        if (hipGetDevice(&dev) != hipSuccess || hipDeviceGetAttribute(&cus, hipDeviceAttributeMultiprocessorCount, dev) != hipSuccess) { fprintf(stderr, "kernel_launch: device query failed\n"); grid = -1; return; }
        if (hipFuncSetAttribute((const void*)mk_fwd, hipFuncAttributeMaxDynamicSharedMemorySize, LDS_BYTES) != hipSuccess) { fprintf(stderr, "kernel_launch: hipFuncSetAttribute failed\n"); grid = -1; return; }
        if (hipOccupancyMaxActiveBlocksPerMultiprocessor(&per_cu, (const void*)mk_fwd, NWAVES * 64, LDS_BYTES) != hipSuccess || per_cu < 1) fprintf(stderr, "kernel_launch: note: occupancy query reports %d workgroups per CU\n", per_cu);
        (void)hipGetLastError();
        grid = cus;
    }
    if (grid < 0) return;
    if (hipMemsetAsync((char*)d_ws + WS_CTL, 0, CTL_ZERO_BYTES, stream) != hipSuccess) { fprintf(stderr, "kernel_launch: memset failed\n"); return; }
    Args a{};
    for (int i = 0; i < 23; ++i) a.in[i] = d_in[i];
    a.out = (float*)d_out; a.ws = (unsigned char*)d_ws;
    hipLaunchKernelGGL(mk_fwd, dim3(grid), dim3(NWAVES * 64), LDS_BYTES, stream, a);
    const hipError_t le = hipPeekAtLastError();
    if (le != hipSuccess) fprintf(stderr, "kernel_launch: launch failed: %s\n", hipGetErrorName(le));
}
```

```cpp
#include <hip/hip_runtime.h>
#include <hip/hip_bf16.h>
#include <cstdio>
#include <cstdint>
namespace pg8 {
#define PG8_LAS __attribute__((address_space(3)))
typedef unsigned short bf16_t;
typedef short bf16x8 __attribute__((ext_vector_type(8)));
typedef float f32x4 __attribute__((ext_vector_type(4)));
typedef unsigned u32x4 __attribute__((ext_vector_type(4)));
constexpr int BM = 256, BK = 64, HALF = 128, HTB = HALF * BK * 2  , STAGE_BYTES = 8 * HTB, NXCD = 8, WGM = 8;

__host__ __device__ __forceinline__ int lds_byte(int r, int c) { const int st = (r >> 4) * 2 + (c >> 5), rr = r & 15, cc = c & 31, ob = rr * 64 + cc * 2; return st * 1024 + (ob ^ (((ob >> 9) & 1) << 5)); }
__host__ __device__ __forceinline__ void stage_rc(int b, int& R, int& C) { const int st = b / 1024, sb = b % 1024, swz = sb ^ (((sb >> 9) & 1) << 5); R = (st >> 1) * 16 + swz / 64; C = (st & 1) * 32 + (swz % 64) / 2; }
__host__ __device__ __forceinline__ int perm32(int rho) { const int n = rho >> 4, i = rho & 15; return 8 * (i >> 2) + 4 * n + (i & 3); }

struct Unit { int pm, pn; };
struct Gemm { const bf16_t* A; const bf16_t* Bt; int M, N, K, ld = 0, ablk = 0; };

struct StaticOrder {
    int nM, nN, nwg, G, c;
    __host__ __device__ void init(int M, int N, int G_, int c_) { nM = M / BM; nN = N / BM; nwg = nM * nN; G = G_; c = c_; }
    __host__ __device__ bool next(int i, Unit& u) const {
        const long L = (long)i * G + c; if (L >= nwg) return false;
        int wgid = (int)L; { const int q = nwg / NXCD, r = nwg % NXCD, xcd = wgid % NXCD, off = wgid / NXCD; wgid = (xcd < r ? xcd * (q + 1) : r * (q + 1) + (xcd - r) * q) + off; }
        const int nig = WGM * nN, gid = wgid / nig, fm = gid * WGM, gsz = (nM - fm) < WGM ? (nM - fm) : WGM;
        u.pm = fm + ((wgid % nig) % gsz); u.pn = (wgid % nig) / gsz; return true;
    }
    __device__ __forceinline__ void a_ready(const Unit&) const {}
    __device__ __forceinline__ void done(const Unit&) const {}
};
struct LimitedOrder : StaticOrder { int maxi; __host__ __device__ bool next(int i, Unit& u) const { return i < maxi && StaticOrder::next(i, u); } };
struct OneUnitOrder : StaticOrder { int round, cu; __host__ __device__ bool next(int i, Unit& u) const { if (i != 0) return false; StaticOrder t = *this; t.c = cu; return t.next(round, u); } };
typedef __bf16 bf16x2_t __attribute__((ext_vector_type(2)));
typedef float f32x2_t __attribute__((ext_vector_type(2)));
__device__ __forceinline__ unsigned cvt_pk_bf16(float lo, float hi) { const f32x2_t v = {lo, hi}; const bf16x2_t b = __builtin_convertvector(v, bf16x2_t); return __builtin_bit_cast(unsigned, b); }
typedef float f32x2 __attribute__((ext_vector_type(2)));
__device__ __forceinline__ float sigm(float x) { return __builtin_amdgcn_rcpf(1.f + __builtin_amdgcn_exp2f(-1.4426950408889634f * x)); }
__device__ __forceinline__ u32x4 pack8(f32x4 a, f32x4 b) { u32x4 w; w.x = cvt_pk_bf16(a[0], a[1]); w.y = cvt_pk_bf16(a[2], a[3]); w.z = cvt_pk_bf16(b[0], b[1]); w.w = cvt_pk_bf16(b[2], b[3]); return w; }
__device__ __forceinline__ void unpack8(u32x4 w, f32x4& a, f32x4& b) {
    a[0] = __builtin_bit_cast(float, w.x << 16); a[1] = __builtin_bit_cast(float, w.x & 0xffff0000u); a[2] = __builtin_bit_cast(float, w.y << 16); a[3] = __builtin_bit_cast(float, w.y & 0xffff0000u);
    b[0] = __builtin_bit_cast(float, w.z << 16); b[1] = __builtin_bit_cast(float, w.z & 0xffff0000u); b[2] = __builtin_bit_cast(float, w.w << 16); b[3] = __builtin_bit_cast(float, w.w & 0xffff0000u); }

struct EpiSwiGLU {
    static constexpr bool PERM = true, AFTER_DRAIN = false;
    bf16_t* O; int ldc;
    __device__ __forceinline__ void operator()(const f32x4 (&acc)[2][2][4][2], const Unit& u, int wr, int wc, int fr, int fq) const {
        const int row0 = u.pm * BM + wr * 64 + fr, col0 = u.pn * HALF + wc * 32 + 8 * fq;
#pragma unroll
        for (int ai = 0; ai < 2; ++ai)
#pragma unroll
            for (int m = 0; m < 4; ++m) { bf16_t* rowp = O + ((size_t)u.pm * (ldc >> 6) + (col0 >> 6)) * (BM * 64) + (size_t)(wr * 64 + fr + ai * HALF + m * 16) * 64 + (col0 & 63);
                f32x4 v[2];
#pragma unroll
                for (int n = 0; n < 2; ++n) { const f32x4 g = acc[ai][0][m][n], up = acc[ai][1][m][n];
#pragma unroll
                    for (int i = 0; i < 4; ++i) v[n][i] = g[i] * up[i] * sigm(g[i]); }
                *(u32x4*)rowp = pack8(v[0], v[1]); }
    }
};

struct EpiSlabStore {
    static constexpr bool PERM = true, AFTER_DRAIN = false;
    float* slab; unsigned* flag;
    __device__ __forceinline__ void operator()(const f32x4 (&acc)[2][2][4][2], const Unit&, int wr, int wc, int fr, int fq) const {
        f32x4* sp = (f32x4*)slab + (size_t)(wr * 4 + wc) * 32 * 64 + (fq * 16 + fr);
#pragma unroll
        for (int ai = 0; ai < 2; ++ai)
#pragma unroll
            for (int bj = 0; bj < 2; ++bj)
#pragma unroll
                for (int m = 0; m < 4; ++m)
#pragma unroll
                    for (int n = 0; n < 2; ++n) sp[(((ai * 2 + bj) * 4 + m) * 2 + n) * 64] = acc[ai][bj][m][n];
        asm volatile("s_waitcnt vmcnt(0)" ::: "memory"); __builtin_amdgcn_s_barrier(); asm volatile("" ::: "memory");
        if (wr == 0 && wc == 0 && fr == 0 && fq == 0) { __builtin_amdgcn_fence(__ATOMIC_RELEASE, "agent"); asm volatile("s_waitcnt vmcnt(0)" ::: "memory");
            __hip_atomic_store(flag, 1u, __ATOMIC_RELAXED, __HIP_MEMORY_SCOPE_AGENT); }
    }
};
struct EpiSlabSwiGLU {
    static constexpr bool PERM = true, AFTER_DRAIN = false;
    bf16_t* O; int ldc; const float* slab; unsigned* flag; unsigned* tmo;
    __device__ __forceinline__ void operator()(const f32x4 (&acc)[2][2][4][2], const Unit& u, int wr, int wc, int fr, int fq) const {
        if (wr == 0 && wc == 0 && fr == 0 && fq == 0) { unsigned sp = 0;
            while (__hip_atomic_load(flag, __ATOMIC_RELAXED, __HIP_MEMORY_SCOPE_AGENT) == 0u) { __builtin_amdgcn_s_sleep(1);
                if ((++sp & 255u) == 0u) { if (__hip_atomic_load(tmo, __ATOMIC_RELAXED, __HIP_MEMORY_SCOPE_AGENT)) break; if (sp > (1u << 18)) { atomicAdd(tmo, 1u); break; } } }
            __builtin_amdgcn_fence(__ATOMIC_ACQUIRE, "agent"); asm volatile("s_waitcnt vmcnt(0)" ::: "memory"); }
        asm volatile("" ::: "memory"); __builtin_amdgcn_s_barrier(); asm volatile("" ::: "memory");
        const f32x4* sp = (const f32x4*)slab + (size_t)(wr * 4 + wc) * 32 * 64 + (fq * 16 + fr);
        const int row0 = u.pm * BM + wr * 64 + fr, col0 = u.pn * HALF + wc * 32 + 8 * fq;
#pragma unroll
        for (int ai = 0; ai < 2; ++ai)
#pragma unroll
            for (int m = 0; m < 4; ++m) { bf16_t* rowp = O + ((size_t)u.pm * (ldc >> 6) + (col0 >> 6)) * (BM * 64) + (size_t)(wr * 64 + fr + ai * HALF + m * 16) * 64 + (col0 & 63);
                f32x4 v[2];
#pragma unroll
                for (int n = 0; n < 2; ++n) { const f32x4 g = acc[ai][0][m][n] + sp[(((ai * 2 + 0) * 4 + m) * 2 + n) * 64], up = acc[ai][1][m][n] + sp[(((ai * 2 + 1) * 4 + m) * 2 + n) * 64];
#pragma unroll
                    for (int i = 0; i < 4; ++i) v[n][i] = g[i] * up[i] * sigm(g[i]); }
                *(u32x4*)rowp = pack8(v[0], v[1]); }
    }
};

struct EpiResid {
    static constexpr bool PERM = false, AFTER_DRAIN = false;
    const float* R; float* C; const float* gv;
    __device__ __forceinline__ void operator()(const f32x4 (&acc)[2][2][4][2], const Unit& u, int wr, int wc, int fr, int fq) const {
        const int row0 = u.pm * BM + wr * 64 + fr, col0 = u.pn * BM + wc * 32 + 4 * fq; const int b = u.pm >> 4;
        f32x4 g[2][2];
#pragma unroll
        for (int bj = 0; bj < 2; ++bj)
#pragma unroll
            for (int n = 0; n < 2; ++n) g[bj][n] = *(const f32x4*)(gv + b * 4096 + col0 + bj * HALF + n * 16);
#pragma unroll
        for (int ai = 0; ai < 2; ++ai)
#pragma unroll
            for (int m = 0; m < 4; ++m) { const size_t off = (size_t)(row0 + ai * HALF + m * 16) * 4096 + col0;
#pragma unroll
                for (int bj = 0; bj < 2; ++bj)
#pragma unroll
                    for (int n = 0; n < 2; ++n) { const f32x4 r = *(const f32x4*)(R + off + bj * HALF + n * 16); *(f32x4*)(C + off + bj * HALF + n * 16) = r + g[bj][n] * acc[ai][bj][m][n]; } }
    }
};

template <bool R_F32> struct EpiResidB {
    static constexpr bool PERM = true, AFTER_DRAIN = false;
    const void* R; bf16_t* C; const float* gv;
    __device__ __forceinline__ void operator()(const f32x4 (&acc)[2][2][4][2], const Unit& u, int wr, int wc, int fr, int fq) const {
        const int row0 = u.pm * BM + wr * 64 + fr, col0 = u.pn * BM + wc * 32 + 8 * fq; const int b = u.pm >> 4;
        f32x4 g[2][2];
#pragma unroll
        for (int bj = 0; bj < 2; ++bj)
#pragma unroll
            for (int n = 0; n < 2; ++n) g[bj][n] = *(const f32x4*)(gv + b * 4096 + col0 + bj * HALF + 4 * n);
#pragma unroll
        for (int ai = 0; ai < 2; ++ai)
#pragma unroll
            for (int m = 0; m < 4; ++m) { const size_t off = (size_t)(row0 + ai * HALF + m * 16) * 4096 + col0;
#pragma unroll
                for (int bj = 0; bj < 2; ++bj) { f32x4 r0, r1;
                    if (R_F32) { r0 = *(const f32x4*)((const float*)R + off + bj * HALF); r1 = *(const f32x4*)((const float*)R + off + bj * HALF + 4); }
                    else unpack8(*(const u32x4*)((const bf16_t*)R + off + bj * HALF), r0, r1);
                    *(u32x4*)(C + off + bj * HALF) = pack8(r0 + g[bj][0] * acc[ai][bj][m][0], r1 + g[bj][1] * acc[ai][bj][m][1]); } }
    }
};

struct EpiProj {
    static constexpr bool PERM = true, AFTER_DRAIN = false;
    bf16_t* qkv; bf16_t* gates; const float* bgate; const float* ropec; const float* ropes;
    __device__ __forceinline__ void operator()(const f32x4 (&acc)[2][2][4][2], const Unit& u, int wr, int wc, int fr, int fq) const {
        const int t = u.pn >> 3, b = u.pm >> 4, s0 = (u.pm & 15) * 256 + wr * 64 + fr;
        if (t < 6) {
            bf16_t* base = qkv + (size_t)t * ((size_t)16384 * 2048);
            const bool rope = (t == 3 || t == 4) && wc == 0;
#pragma unroll
            for (int bj = 0; bj < 2; ++bj) { const int head = (u.pn & 7) * 2 + bj; bf16_t* hb = base + (size_t)(b * 16 + head) * 4096 * 128;
#pragma unroll
                for (int ai = 0; ai < 2; ++ai)
#pragma unroll
                    for (int m = 0; m < 4; ++m) { const int s = s0 + ai * HALF + m * 16; bf16_t* p = hb + (size_t)s * 128;
                        const f32x4 v0 = acc[ai][bj][m][0], v1 = acc[ai][bj][m][1];
                        if (rope) { const size_t ri = ((size_t)b * 4096 + s) * 16 + 4 * fq; const f32x4 cs = *(const f32x4*)(ropec + ri), sn = *(const f32x4*)(ropes + ri);
                            const f32x4 lo = v0 * cs - v1 * sn, hi = v1 * cs + v0 * sn;
                            typedef unsigned u32x2 __attribute__((ext_vector_type(2)));
                            u32x2 a, c2; a.x = cvt_pk_bf16(lo[0], lo[1]); a.y = cvt_pk_bf16(lo[2], lo[3]); c2.x = cvt_pk_bf16(hi[0], hi[1]); c2.y = cvt_pk_bf16(hi[2], hi[3]);
                            *(u32x2*)(p + 4 * fq) = a; *(u32x2*)(p + 16 + 4 * fq) = c2; }
                        else *(u32x4*)(p + wc * 32 + 8 * fq) = pack8(v0, v1); } }
        } else {
            const int row0 = u.pm * BM + wr * 64 + fr, col0 = (u.pn - 48) * BM + wc * 32 + 8 * fq;
            f32x4 bv[2][2];
#pragma unroll
            for (int bj = 0; bj < 2; ++bj)
#pragma unroll
                for (int n = 0; n < 2; ++n) bv[bj][n] = *(const f32x4*)(bgate + col0 + bj * HALF + 4 * n);
#pragma unroll
            for (int ai = 0; ai < 2; ++ai)
#pragma unroll
                for (int m = 0; m < 4; ++m) { bf16_t* rowp = gates + ((size_t)(u.pm * 32 + (u.pn - 48)) * 65536 + (wr * 4 + wc) * 8192 + (ai * 4 + m) * 1024 + (fq * 16 + fr) * 8);
#pragma unroll
                    for (int bj = 0; bj < 2; ++bj) { f32x4 v0 = acc[ai][bj][m][0] + bv[bj][0], v1 = acc[ai][bj][m][1] + bv[bj][1];
#pragma unroll
                        for (int i = 0; i < 4; ++i) { v0[i] = sigm(v0[i]); v1[i] = sigm(v1[i]); }
                        *(u32x4*)(rowp + bj * 512) = pack8(v0, v1); } }
        }
    }
};

template <bool FIRST> struct EpiMerge {
    static constexpr bool PERM = true, AFTER_DRAIN = false;
    const bf16_t* G; int goff; const bf16_t* T; bf16_t* O;
    __device__ __forceinline__ void operator()(const f32x4 (&acc)[2][2][4][2], const Unit& u, int wr, int wc, int fr, int fq) const {
        const int row0 = u.pm * BM + wr * 64 + fr, col0 = u.pn * BM + wc * 32 + 8 * fq;
#pragma unroll
        for (int ai = 0; ai < 2; ++ai)
#pragma unroll
            for (int m = 0; m < 4; ++m) { const size_t row = (size_t)(row0 + ai * HALF + m * 16);
#pragma unroll
                for (int bj = 0; bj < 2; ++bj) { f32x4 g0, g1; unpack8(*(const u32x4*)(G + ((size_t)(u.pm * 32 + (goff >> 8) + u.pn) * 65536 + (wr * 4 + wc) * 8192 + ((ai * 4 + m) * 2 + bj) * 512 + (fq * 16 + fr) * 8)), g0, g1);
                    f32x4 v0 = g0 * acc[ai][bj][m][0], v1 = g1 * acc[ai][bj][m][1];
                    const size_t fo = (size_t)(u.pm * 16 + u.pn) * 65536 + (wr * 4 + wc) * 8192 + ((ai * 4 + m) * 2 + bj) * 512 + (fq * 16 + fr) * 8;
                    if (!FIRST) { f32x4 t0, t1; unpack8(*(const u32x4*)(T + fo), t0, t1); v0 += t0; v1 += t1; }
                    *(u32x4*)(O + (FIRST ? fo : row * 4096 + col0 + bj * HALF)) = pack8(v0, v1); } }
    }
};

template <class Epi, class Sched, bool ALIGN_EPI = false, bool SP2 = false>
__device__ __forceinline__ void gemm_phase(PG8_LAS unsigned char* lds, const Gemm g, const Sched& S, const Epi& E) {
    int tid_l = threadIdx.x; asm volatile("" : "+v"(tid_l)); const int tid = tid_l, wid = __builtin_amdgcn_readfirstlane(tid >> 6), lane = tid & 63, wr = wid >> 2, wc = wid & 3, fr = lane & 15, fq = lane >> 4;
    const int K = g.ld ? g.ld : g.K, nt = g.K / BK;
    unsigned voffA[2], voffB[2];
#pragma unroll
    for (int i = 0; i < 2; ++i) { int R, C; stage_rc(tid * 16 + i * 8192, R, C); const int Rb = Epi::PERM ? ((R & ~31) + perm32(R & 31)) : R;
        voffA[i] = g.ablk ? (unsigned)(R * BK + C) * 2u : (unsigned)(R * K + C) * 2u; voffB[i] = (unsigned)(Rb * K + C) * 2u; }
    const size_t kstep = (size_t)(BK * 2);
    const size_t hstep = (size_t)HALF * K * 2;
    const size_t tstep = 2 * hstep;
    const size_t kstepA = g.ablk ? (size_t)(BM * BK * 2) : kstep, hstepA = g.ablk ? (size_t)(HALF * BK * 2) : hstep;
    const unsigned ldsw = (unsigned)wid * 1024u;
    const int aoff = lds_byte(wr * 64 + fr, fq * 8), boff = lds_byte(wc * 32 + fr, fq * 8);
#define PG8_SA(b, h) (((b) * 2 + (h)) * HTB)
#define PG8_SB(b, h) ((4 + (b) * 2 + (h)) * HTB)
#define PG8_STAGE(bufoff, gbase, voff) do { _Pragma("unroll") for (int _i = 0; _i < 2; ++_i) \
        __builtin_amdgcn_global_load_lds((const unsigned*)((const char*)(gbase) + (voff)[_i]), (PG8_LAS unsigned*)(lds + (bufoff) + ldsw + _i * 8192), 16, 0, 0); } while (0)
#define PG8_LDA(dst, b, h) do { _Pragma("unroll") for (int m = 0; m < 4; ++m) _Pragma("unroll") for (int k = 0; k < 2; ++k) dst[m][k] = *(const PG8_LAS bf16x8*)(lds + PG8_SA(b, h) + aoff + m * 2048 + k * 1024); } while (0)
#define PG8_LDB(dst, b, h) do { _Pragma("unroll") for (int n = 0; n < 2; ++n) _Pragma("unroll") for (int k = 0; k < 2; ++k) dst[n][k] = *(const PG8_LAS bf16x8*)(lds + PG8_SB(b, h) + boff + n * 2048 + k * 1024); } while (0)
#define PG8_MMA(ai, bj, At, Bt) do { __builtin_amdgcn_s_setprio(1); _Pragma("unroll") for (int m = 0; m < 4; ++m) _Pragma("unroll") for (int n = 0; n < 2; ++n) _Pragma("unroll") for (int k = 0; k < 2; ++k) \
        acc[ai][bj][m][n] = __builtin_amdgcn_mfma_f32_16x16x32_bf16(Bt[n][k], At[m][k], acc[ai][bj][m][n], 0, 0, 0); __builtin_amdgcn_s_setprio(0); } while (0)
#define PG8_WAIT_V(n) asm volatile("s_waitcnt vmcnt(" #n ")" ::: "memory")
#define PG8_WAIT_L(n) asm volatile("s_waitcnt lgkmcnt(" #n ")" ::: "memory")
#define PG8_BAR __builtin_amdgcn_s_barrier()
#define PG8_SCHED __builtin_amdgcn_sched_barrier(0)
    Unit cur, nxt; int ui = 0;
    if (!S.next(0, cur)) return;
    f32x4 acc[2][2][4][2];
#pragma unroll
    for (int a = 0; a < 2; ++a)
#pragma unroll
        for (int b = 0; b < 2; ++b)
#pragma unroll
            for (int m = 0; m < 4; ++m)
#pragma unroll
                for (int n = 0; n < 2; ++n) acc[a][b][m][n] = (f32x4){0.f, 0.f, 0.f, 0.f};
    bf16x8 At[4][2], B0[2][2], B1[2][2];
    const char* cA = (const char*)g.A + (size_t)cur.pm * tstep; const char* cB = (const char*)g.Bt + (size_t)cur.pn * tstep;
    S.a_ready(cur);
    if constexpr (SP2) {
        PG8_STAGE(PG8_SB(0, 0), cB, voffB); PG8_STAGE(PG8_SB(0, 1), cB + hstep, voffB); PG8_STAGE(PG8_SA(0, 0), cA, voffA); PG8_STAGE(PG8_SA(0, 1), cA + hstepA, voffA);
        if (wr == 1) PG8_BAR;
        PG8_WAIT_V(2); PG8_BAR;
        PG8_STAGE(PG8_SB(1, 0), cB + kstep, voffB); PG8_STAGE(PG8_SA(1, 0), cA + kstepA, voffA); PG8_STAGE(PG8_SB(1, 1), cB + hstep + kstep, voffB);
        PG8_WAIT_V(6); PG8_BAR;
    } else {
        PG8_STAGE(PG8_SB(0, 0), cB, voffB); PG8_STAGE(PG8_SA(0, 0), cA, voffA); PG8_STAGE(PG8_SB(0, 1), cB + hstep, voffB); PG8_STAGE(PG8_SA(0, 1), cA + hstepA, voffA);
        if (wr == 1) PG8_BAR;
        PG8_WAIT_V(4); PG8_BAR;
        PG8_STAGE(PG8_SB(1, 0), cB + kstep, voffB); PG8_STAGE(PG8_SA(1, 0), cA + kstepA, voffA); PG8_STAGE(PG8_SB(1, 1), cB + hstep + kstep, voffB);
        PG8_WAIT_V(6); PG8_BAR;
    }
    for (;;) {
        const bool has_next = S.next(ui + 1, nxt);
        const char* nA = has_next ? (const char*)g.A + (size_t)nxt.pm * tstep : cA; const char* nB = has_next ? (const char*)g.Bt + (size_t)nxt.pn * tstep : cB;
        for (int t = 0; t < nt; t += 2) {
            const bool last = (t == nt - 2);
            const char* a1 = cA + (size_t)(t + 1) * kstepA;
            const char* a2 = last ? nA : cA + (size_t)(t + 2) * kstepA; const char* b2 = last ? nB : cB + (size_t)(t + 2) * kstep;
            const char* a3 = a2 + kstepA; const char* b3 = b2 + kstep;
            if (last && has_next) S.a_ready(nxt);
            if constexpr (SP2) {
            PG8_LDB(B0, 0, 0); PG8_LDB(B1, 0, 1); PG8_SCHED; PG8_LDA(At, 0, 0); PG8_STAGE(PG8_SA(1, 1), a1 + hstepA, voffA);
            PG8_WAIT_V(8); PG8_WAIT_L(0); PG8_BAR; PG8_MMA(0, 0, At, B0); PG8_MMA(0, 1, At, B1); PG8_BAR; PG8_SCHED;
            PG8_LDA(At, 0, 1); PG8_STAGE(PG8_SB(0, 0), b2, voffB); PG8_STAGE(PG8_SB(0, 1), b2 + hstep, voffB); PG8_STAGE(PG8_SA(0, 0), a2, voffA);
            PG8_WAIT_V(8); PG8_WAIT_L(0); PG8_BAR; PG8_MMA(1, 0, At, B0); PG8_MMA(1, 1, At, B1); PG8_BAR; PG8_SCHED;
            PG8_LDB(B0, 1, 0); PG8_LDB(B1, 1, 1); PG8_SCHED; PG8_LDA(At, 1, 0); PG8_STAGE(PG8_SA(0, 1), a2 + hstepA, voffA);
            PG8_WAIT_V(8); PG8_WAIT_L(0); PG8_BAR; PG8_MMA(0, 0, At, B0); PG8_MMA(0, 1, At, B1); PG8_BAR; PG8_SCHED;
            PG8_LDA(At, 1, 1); PG8_STAGE(PG8_SB(1, 0), b3, voffB); PG8_STAGE(PG8_SB(1, 1), b3 + hstep, voffB); PG8_STAGE(PG8_SA(1, 0), a3, voffA);
            PG8_WAIT_V(8); PG8_WAIT_L(0); PG8_BAR; PG8_MMA(1, 0, At, B0); PG8_MMA(1, 1, At, B1); PG8_BAR; PG8_SCHED;
            } else {
            PG8_LDB(B0, 0, 0); PG8_SCHED; PG8_LDA(At, 0, 0); PG8_STAGE(PG8_SA(1, 1), a1 + hstepA, voffA);
            PG8_WAIT_L(8); PG8_BAR; PG8_WAIT_L(0); PG8_MMA(0, 0, At, B0); PG8_BAR; PG8_SCHED;
            PG8_LDB(B1, 0, 1); PG8_STAGE(PG8_SB(0, 0), b2, voffB);
            PG8_BAR; PG8_WAIT_L(0); PG8_MMA(0, 1, At, B1); PG8_BAR;
            PG8_LDA(At, 0, 1); PG8_STAGE(PG8_SA(0, 0), a2, voffA);
            PG8_BAR; PG8_WAIT_L(0); PG8_MMA(1, 0, At, B0); PG8_BAR; PG8_SCHED;
            PG8_STAGE(PG8_SB(0, 1), b2 + hstep, voffB);
            PG8_WAIT_V(6); PG8_BAR; PG8_MMA(1, 1, At, B1); PG8_BAR;
            PG8_LDB(B0, 1, 0); PG8_SCHED; PG8_LDA(At, 1, 0); PG8_STAGE(PG8_SA(0, 1), a2 + hstepA, voffA);
            PG8_WAIT_L(8); PG8_BAR; PG8_WAIT_L(0); PG8_MMA(0, 0, At, B0); PG8_BAR; PG8_SCHED;
            PG8_LDB(B1, 1, 1); PG8_STAGE(PG8_SB(1, 0), b3, voffB);
            PG8_BAR; PG8_WAIT_L(0); PG8_MMA(0, 1, At, B1); PG8_BAR;
            PG8_LDA(At, 1, 1); PG8_STAGE(PG8_SA(1, 0), a3, voffA);
            PG8_BAR; PG8_WAIT_L(0); PG8_MMA(1, 0, At, B0); PG8_BAR; PG8_SCHED;
            PG8_STAGE(PG8_SB(1, 1), b3 + hstep, voffB);
            PG8_WAIT_V(6); PG8_BAR; PG8_MMA(1, 1, At, B1); PG8_BAR;
            }
        }
        if constexpr (ALIGN_EPI) { if (wr == 0) PG8_BAR; }
        if constexpr (!Epi::AFTER_DRAIN) { E(acc, cur, wr, wc, fr, fq); S.done(cur); }
        if (!has_next) break;
#pragma unroll
        for (int a = 0; a < 2; ++a)
#pragma unroll
            for (int b = 0; b < 2; ++b)
#pragma unroll
                for (int m = 0; m < 4; ++m)
#pragma unroll
                    for (int n = 0; n < 2; ++n) acc[a][b][m][n] = (f32x4){0.f, 0.f, 0.f, 0.f};
        cur = nxt; cA = nA; cB = nB; ++ui;
        if constexpr (ALIGN_EPI) { if (wr == 1) PG8_BAR; }
    }
    PG8_WAIT_V(0);
    if constexpr (!ALIGN_EPI) { if (wr == 0) PG8_BAR; }
    PG8_BAR;
    if constexpr (Epi::AFTER_DRAIN) { E.fused(acc, cur, wr, wc, fr, fq, lds, wid, lane); S.done(cur); }
#undef PG8_SA
#undef PG8_SB
#undef PG8_STAGE
#undef PG8_LDA
#undef PG8_LDB
#undef PG8_MMA
#undef PG8_WAIT_V
#undef PG8_WAIT_L
#undef PG8_BAR
#undef PG8_SCHED
}
}
namespace att {
using bf16 = __hip_bfloat16;
typedef short bf16x8 __attribute__((ext_vector_type(8)));
typedef short s16x4 __attribute__((ext_vector_type(4)));
typedef float f32x16 __attribute__((ext_vector_type(16)));
typedef float f32x4 __attribute__((ext_vector_type(4)));
typedef unsigned u32x4 __attribute__((ext_vector_type(4)));
constexpr int D = 128;
constexpr float SCALE = 0.08838834764831845f;
constexpr float THR = 8.f;
constexpr int NW = 8, QBLK = 32, KVBLK = 64, QB = NW * QBLK;
constexpr int SHM_V = KVBLK * D * 2, SHM_K = KVBLK * D * 2;
constexpr int OFF_WS = 2 * SHM_V + 2 * SHM_K;
constexpr int OFF_BIAS = OFF_WS + NW * 64 * 4;
constexpr int LDS_BYTES = OFF_BIAS + 4096 * 4;
constexpr unsigned WINF = 0x7fffffffu;

#define KSWZ(row, colB) ((row) * 256 + ((colB) ^ (((row) & 7) << 4)))
#define SBAR() __builtin_amdgcn_sched_barrier(0)
__device__ __forceinline__ int v_st(int k, int c) { const int kk = (k & ~0xC) | ((k & 4) << 1) | ((k & 8) >> 1); return ((kk >> 3) * 4 + (c >> 5)) * 512 + ((kk & 7) * 32 + (c & 31)) * 2; }
__device__ __forceinline__ int v_rd_base(int lane) { return ((lane & 3) << 3) | (((lane >> 2) & 3) << 6) | (((lane >> 4) & 1) << 5) | (((lane >> 5) & 1) << 8); }
constexpr int v_rd_off(int d0, int ks, int half) { return d0 * 512 + ks * 4096 + half * 2048; }
__device__ __forceinline__ int crow(int r, int hi) { return (r & 3) + 8 * (r >> 2) + 4 * hi; }
typedef __bf16 bf16x2_t __attribute__((ext_vector_type(2)));
typedef float f32x2_t __attribute__((ext_vector_type(2)));
__device__ __forceinline__ unsigned cvtpk(float lo, float hi) { const f32x2_t v = {lo, hi}; const bf16x2_t b = __builtin_convertvector(v, bf16x2_t); return __builtin_bit_cast(unsigned, b); }
__device__ __forceinline__ bf16x8 load8(const bf16* p) { return *reinterpret_cast<const bf16x8*>(p); }
__device__ __forceinline__ void mask_tile(f32x16& p0, f32x16& p1, int dq, unsigned W) {
    const float NEG = -__builtin_inff();
#pragma unroll
    for (int r = 0; r < 16; ++r) {
        const int c = (r & 3) + 8 * (r >> 2);
        if ((unsigned)(dq - c) >= W) p0[r] = NEG;
        if ((unsigned)(dq - c - 32) >= W) p1[r] = NEG;
    }
}
__device__ __forceinline__ void partialSM(f32x16& p0, f32x16& p1, float& m_reg, float& mn, float& alpha) {
    float pmax = p0[0]; for (int r = 1; r < 16; ++r) pmax = fmaxf(pmax, p0[r]); for (int r = 0; r < 16; ++r) pmax = fmaxf(pmax, p1[r]);
    { auto rr = __builtin_amdgcn_permlane32_swap(__float_as_uint(pmax), __float_as_uint(pmax), false, false);
      pmax = fmaxf(__uint_as_float(rr[0]), __uint_as_float(rr[1])); }
    constexpr float C2 = 1.4426950408889634f * SCALE;
    if (__builtin_expect(__all((pmax - m_reg) * SCALE <= THR), 1)) { mn = m_reg; alpha = 1.f; }
    else { mn = fmaxf(m_reg, pmax); alpha = __builtin_amdgcn_exp2f((m_reg - mn) * C2); m_reg = mn; }
    const float mnL = -mn * C2;
    for (int r = 0; r < 16; ++r) p0[r] = fmaf(p0[r], C2, mnL); for (int r = 0; r < 16; ++r) p1[r] = fmaf(p1[r], C2, mnL);
    for (int r = 0; r < 16; ++r) p0[r] = __builtin_amdgcn_exp2f(p0[r]);
}
__device__ __forceinline__ void finishSM(f32x16& p0, f32x16& p1, float alpha, float& l_reg, bf16x8& pa0, bf16x8& pa1, bf16x8& pa2, bf16x8& pa3) {
    for (int r = 0; r < 16; ++r) p1[r] = __builtin_amdgcn_exp2f(p1[r]);
    float ps = 0; for (int r = 0; r < 16; ++r) ps += p0[r]; for (int r = 0; r < 16; ++r) ps += p1[r];
    { auto rr = __builtin_amdgcn_permlane32_swap(__float_as_uint(ps), __float_as_uint(ps), false, false);
      ps = __uint_as_float(rr[0]) + __uint_as_float(rr[1]); }
    l_reg = l_reg * alpha + ps;
#define PK4(P, B_, OUT) do { unsigned a0 = cvtpk(P[B_+0], P[B_+1]), a1 = cvtpk(P[B_+2], P[B_+3]);                          \
        unsigned b0 = cvtpk(P[B_+4], P[B_+5]), b1 = cvtpk(P[B_+6], P[B_+7]);                                             \
        auto r0 = __builtin_amdgcn_permlane32_swap(a0, b0, false, false); auto r1 = __builtin_amdgcn_permlane32_swap(a1, b1, false, false); \
        u32x4 w = {r0[0], r1[0], r0[1], r1[1]}; OUT = *reinterpret_cast<bf16x8*>(&w); } while (0)
    PK4(p0, 0, pa0); PK4(p0, 8, pa1); PK4(p1, 0, pa2); PK4(p1, 8, pa3);
#undef PK4
}
template <int KB>
__device__ __forceinline__ void qkt(f32x16& p0, f32x16& p1, const char* K_lds, int r32, int hi, const bf16x8* qr, const float* bt) {
    { const f32x4 a0 = *(const f32x4*)(bt), a1 = *(const f32x4*)(bt + 8), a2 = *(const f32x4*)(bt + 16), a3 = *(const f32x4*)(bt + 24);
      const f32x4 c0 = *(const f32x4*)(bt + 32), c1 = *(const f32x4*)(bt + 40), c2 = *(const f32x4*)(bt + 48), c3 = *(const f32x4*)(bt + 56);
      p0 = (f32x16){a0[0], a0[1], a0[2], a0[3], a1[0], a1[1], a1[2], a1[3], a2[0], a2[1], a2[2], a2[3], a3[0], a3[1], a3[2], a3[3]};
      p1 = (f32x16){c0[0], c0[1], c0[2], c0[3], c1[0], c1[1], c1[2], c1[3], c2[0], c2[1], c2[2], c2[3], c3[0], c3[1], c3[2], c3[3]}; }
    const char* kb[4];
#pragma unroll
    for (int dd = 0; dd < 4; ++dd) kb[dd] = K_lds + KB * SHM_K + KSWZ(r32, (dd * 16 + hi * 8) * 2);
#pragma unroll
    for (int d0 = 0; d0 < 8; ++d0) { const char* a = kb[d0 & 3] + (d0 >> 2) * 128;
        bf16x8 b0 = *reinterpret_cast<const bf16x8*>(a);
        bf16x8 b1 = *reinterpret_cast<const bf16x8*>(a + 32 * 256);
        p0 = __builtin_amdgcn_mfma_f32_32x32x16_bf16(b0, qr[d0], p0, 0, 0, 0);
        p1 = __builtin_amdgcn_mfma_f32_32x32x16_bf16(b1, qr[d0], p1, 0, 0, 0); }
}
template <int VB>
__device__ __forceinline__ void pv_tile(f32x16* o, int vb0, bf16x8 pa0, bf16x8 pa1, bf16x8 pa2, bf16x8 pa3) {
#define TRRD(dst, off) asm volatile("ds_read_b64_tr_b16 %0, %1 offset:%2" : "=&v"(dst) : "v"(vb0), "i"(off) : "memory")
#define PV_D0(d0) do { s16x4 l0, l1, l2, l3, h0, h1, h2, h3; constexpr int b_ = VB * SHM_V + v_rd_off(d0, 0, 0);   \
        TRRD(l0, b_); TRRD(h0, b_ + 2048); TRRD(l1, b_ + 4096); TRRD(h1, b_ + 6144); TRRD(l2, b_ + 8192); TRRD(h2, b_ + 10240); TRRD(l3, b_ + 12288); TRRD(h3, b_ + 14336); \
        asm volatile("s_waitcnt lgkmcnt(0)" ::: "memory"); SBAR();   \
        o[d0] = __builtin_amdgcn_mfma_f32_32x32x16_bf16(pa0, (bf16x8){l0[0], l0[1], l0[2], l0[3], h0[0], h0[1], h0[2], h0[3]}, o[d0], 0, 0, 0);   \
        o[d0] = __builtin_amdgcn_mfma_f32_32x32x16_bf16(pa1, (bf16x8){l1[0], l1[1], l1[2], l1[3], h1[0], h1[1], h1[2], h1[3]}, o[d0], 0, 0, 0);   \
        o[d0] = __builtin_amdgcn_mfma_f32_32x32x16_bf16(pa2, (bf16x8){l2[0], l2[1], l2[2], l2[3], h2[0], h2[1], h2[2], h2[3]}, o[d0], 0, 0, 0);   \
        o[d0] = __builtin_amdgcn_mfma_f32_32x32x16_bf16(pa3, (bf16x8){l3[0], l3[1], l3[2], l3[3], h3[0], h3[1], h3[2], h3[3]}, o[d0], 0, 0, 0); } while (0)
    PV_D0(0); PV_D0(1); PV_D0(2); PV_D0(3);
#undef PV_D0
#undef TRRD
}

struct BlockRef { const bf16* Q; const bf16* K; const bf16* V; bf16* O; const float* kb; int P0, opitch, CH, jlo; };
struct Seam { bf16x8 qr[8]; bf16x8 st_v0, st_v1, st_k0, st_k1; };
#define ROW(p, k0, rr) ((p) + (size_t)((k0) + (rr)) * D + sc)
#define VMW() asm volatile("s_waitcnt vmcnt(0)" ::: "memory")
#define VMWN(n) asm volatile("s_waitcnt vmcnt(%0)" :: "i"(n) : "memory")
#define SLOAD_H(Kp, Vp, k0) do { S.st_v0 = load8(ROW(Vp, k0, sr)); S.st_v1 = load8(ROW(Vp, k0, 32 + sr));              \
                         S.st_k0 = load8(ROW(Kp, k0, sr)); S.st_k1 = load8(ROW(Kp, k0, 32 + sr)); } while (0)
#define SWRITE_HK(bf) do { *(bf16x8*)(K_lds + (bf) * SHM_K + kws) = S.st_k0; *(bf16x8*)(K_lds + (bf) * SHM_K + kws + 32 * 256) = S.st_k1; } while (0)
#define SWRITE_HV(bf) do { *(bf16x8*)(V_lds + (bf) * SHM_V + vst0) = S.st_v0; *(bf16x8*)(V_lds + (bf) * SHM_V + vst1) = S.st_v1; } while (0)
#define SWRITE_H(bf) do { SWRITE_HV(bf); SWRITE_HK(bf); } while (0)
__device__ __forceinline__ void block_prime(const BlockRef& cur, char* lds, Seam& S) {
    int tid_l = threadIdx.x; asm volatile("" : "+v"(tid_l)); const int tid = tid_l, wid = __builtin_amdgcn_readfirstlane(tid >> 6), lane = tid & 63, r32 = lane & 31, hi = lane >> 5;
    const int sr = tid >> 4, sc = (tid & 15) * 8, kws = KSWZ(sr, sc * 2); char* K_lds = lds + 2 * SHM_V;
    for (int d0 = 0; d0 < 8; ++d0) S.qr[d0] = load8(cur.Q + (size_t)(wid * QBLK + r32) * D + d0 * 16 + hi * 8);
    SLOAD_H(cur.K, cur.V, cur.jlo * KVBLK); VMW(); SWRITE_HK(0);
    __syncthreads();
}
__device__ __forceinline__ void block_run(const BlockRef& cur, const BlockRef& nxt, char* lds, Seam& S) {
    int tid_l = threadIdx.x; asm volatile("" : "+v"(tid_l)); const int tid = tid_l, wid = __builtin_amdgcn_readfirstlane(tid >> 6), lane = tid & 63, r32 = lane & 31, hi = lane >> 5;
    const int jlo = cur.jlo, NT = cur.P0 / KVBLK + QB / KVBLK - jlo;
    const int qlo = cur.P0 + wid * QBLK, qlo_m = qlo | cur.CH, qm = ((qlo + r32) | cur.CH) - 4 * hi;
    char* V_lds = lds; char* K_lds = lds + 2 * SHM_V;
    float* ws = (float*)(lds + OFF_WS) + wid * 64; float* li_l = ws, * al_l = ws + 32;
    float* bl = (float*)(lds + OFF_BIAS);
    { const int nk = cur.P0 + QB;
      for (int i = jlo * KVBLK + tid * 4; i < nk; i += 2048) { f32x4 v = {0.f, 0.f, 0.f, 0.f}; if (cur.kb) v = *(const f32x4*)(cur.kb + i); *(f32x4*)(bl + i) = v; }
      __syncthreads(); }
    const float* blh = bl + hi * 4;
    float m_reg = -1e30f, l_reg = 0; f32x16 o[4] = {};
    const int sr = tid >> 4, sc = (tid & 15) * 8, vst0 = v_st(sr, sc), vst1 = v_st(32 + sr, sc), kws = KSWZ(sr, sc * 2);
    const int vb0 = (int)(uintptr_t)V_lds + v_rd_base(lane);
    const bf16* Kh = cur.K; const bf16* Vh = cur.V;
#define RESC(a) do { if (__any((a) < 1.f)) { if (hi == 0) al_l[r32] = (a); asm volatile("s_waitcnt lgkmcnt(0)" ::: "memory");              \
                     for (int d_ = 0; d_ < 4; ++d_) for (int r = 0; r < 16; ++r) o[d_][r] *= al_l[crow(r, hi)]; } } while (0)
#define KBASE(t) ((jlo + (t)) * KVBLK)
#define MASKT(P0_, P1_, t) do { const int kb_ = KBASE(t); if (kb_ + KVBLK - 1 > qlo_m) mask_tile(P0_, P1_, qm - kb_, WINF); } while (0)
#define SEAM_K0() do { VMWN(8); SWRITE_HK(0); SBAR(); } while (0)
    f32x16 pA0, pA1, pB0, pB1; float mnA, mnB, alA, alB; bf16x8 pa0, pa1, pa2, pa3;
    SWRITE_HV(0); SBAR();
    if (NT > 1) SLOAD_H(Kh, Vh, KBASE(1));
    SBAR(); qkt<0>(pA0, pA1, K_lds, r32, hi, S.qr, blh + KBASE(0));
    MASKT(pA0, pA1, 0); partialSM(pA0, pA1, m_reg, mnA, alA);
    if (NT > 1) { VMW(); SWRITE_H(1); }
    __syncthreads();
#define HALF_STEP(PX0, PX1, mnX, alX, PY0, PY1, alY, t, KB, VB, SB) do {                                                      \
        SBAR(); qkt<KB>(PX0, PX1, K_lds, r32, hi, S.qr, blh + KBASE(t));                                                      \
        finishSM(PY0, PY1, alY, l_reg, pa0, pa1, pa2, pa3); SBAR();                                                           \
        if ((t) + 1 < NT) { SLOAD_H(Kh, Vh, KBASE((t) + 1)); SBAR(); }                                                        \
        pv_tile<VB>(o, vb0, pa0, pa1, pa2, pa3); MASKT(PX0, PX1, (t)); partialSM(PX0, PX1, m_reg, mnX, alX);                  \
        __syncthreads();                                                                                                      \
        if ((t) + 1 < NT) { VMW(); SWRITE_H(SB); }                                                                            \
        RESC(alX); __syncthreads(); } while (0)
    for (int t = 1; t + 1 < NT; t += 2) {
        HALF_STEP(pB0, pB1, mnB, alB, pA0, pA1, alA, t, 1, 0, 0);
        HALF_STEP(pA0, pA1, mnA, alA, pB0, pB1, alB, t + 1, 0, 1, 1);
    }
    const bool even = (NT & 1) == 0;
    if (even) { SBAR(); qkt<1>(pB0, pB1, K_lds, r32, hi, S.qr, blh + KBASE(NT - 1)); SBAR(); }
    SLOAD_H(nxt.K, nxt.V, nxt.jlo * KVBLK); SBAR();
#pragma unroll
    for (int d0 = 0; d0 < 8; ++d0) S.qr[d0] = load8(nxt.Q + (size_t)(wid * QBLK + r32) * D + d0 * 16 + hi * 8);
    SBAR();
    finishSM(pA0, pA1, alA, l_reg, pa0, pa1, pa2, pa3); SBAR();
    pv_tile<0>(o, vb0, pa0, pa1, pa2, pa3);
    if (even) { MASKT(pB0, pB1, NT - 1); partialSM(pB0, pB1, m_reg, mnB, alB); __syncthreads(); RESC(alB);
        finishSM(pB0, pB1, alB, l_reg, pa0, pa1, pa2, pa3); SBAR(); pv_tile<1>(o, vb0, pa0, pa1, pa2, pa3); }
    SBAR(); SEAM_K0();
    if (hi == 0) li_l[r32] = l_reg; asm volatile("s_waitcnt lgkmcnt(0)" ::: "memory");
    float rli[16];
#pragma unroll
    for (int r = 0; r < 16; ++r) rli[r] = __builtin_amdgcn_rcpf(li_l[crow(r, hi)]);
    bf16* Ow = cur.O + (size_t)(wid * QBLK) * cur.opitch;
#pragma unroll
    for (int r = 0; r < 16; ++r) { const int orow = crow(r, hi);
#pragma unroll
        for (int d0 = 0; d0 < 4; ++d0) { const float v = o[d0][r] * rli[r];
            const float vn = __shfl_xor(v, 1);
            if ((r32 & 1) == 0) *(unsigned*)(Ow + (size_t)orow * cur.opitch + d0 * 32 + r32) = cvtpk(v, vn); } }
    __syncthreads();
#undef RESC
#undef KBASE
#undef MASKT
#undef SEAM_K0
#undef HALF_STEP
}
#undef ROW
#undef VMW
#undef VMWN
#undef SLOAD_H
#undef SWRITE_HK
#undef SWRITE_HV
#undef SWRITE_H
#undef KSWZ
#undef SBAR
}
namespace att2 {
using namespace att;
constexpr int ROWS = 128, SHM_K2 = 16384, SHM_V2 = 32768, SHM_P2 = 16384;
constexpr int OFF_K = 0, OFF_V = 2 * SHM_K2, OFF_P = OFF_V + 2 * SHM_V2, RING_USED = OFF_P + 2 * SHM_P2;
static_assert(RING_USED <= 131072, "att2 LDS");
#define KSWZ2(row, colB) ((row) * 256 + ((colB) ^ (((row) & 7) << 4)))
#define SBAR2() __builtin_amdgcn_sched_barrier(0)
template <int KB>
__device__ __forceinline__ void qkt0(f32x16& p0, f32x16& p1, const char* K_lds, int r32, int hi, const bf16x8* qr) {
    p0 = f32x16{}; p1 = f32x16{};
    const char* kb[4];
#pragma unroll
    for (int dd = 0; dd < 4; ++dd) kb[dd] = K_lds + KB * SHM_K2 + KSWZ2(r32, (dd * 16 + hi * 8) * 2);
#pragma unroll
    for (int d0 = 0; d0 < 8; ++d0) { const char* a = kb[d0 & 3] + (d0 >> 2) * 128;
        bf16x8 b0 = *reinterpret_cast<const bf16x8*>(a);
        bf16x8 b1 = *reinterpret_cast<const bf16x8*>(a + 32 * 256);
        p0 = __builtin_amdgcn_mfma_f32_32x32x16_bf16(b0, qr[d0], p0, 0, 0, 0);
        p1 = __builtin_amdgcn_mfma_f32_32x32x16_bf16(b1, qr[d0], p1, 0, 0, 0); }
}
template <int VB>
__device__ __forceinline__ void pv2(f32x16* o, int vb0, bf16x8 pa0, bf16x8 pa1, bf16x8 pa2, bf16x8 pa3) {
#define TRRD2(dst, off) asm volatile("ds_read_b64_tr_b16 %0, %1 offset:%2" : "=&v"(dst) : "v"(vb0), "i"(off) : "memory")
#define PV2_D0(hv, d0) do { s16x4 l0, l1, l2, l3, h0, h1, h2, h3; constexpr int b_ = VB * SHM_V2 + (hv) * 16384 + v_rd_off(d0, 0, 0);   \
        TRRD2(l0, b_); TRRD2(h0, b_ + 2048); TRRD2(l1, b_ + 4096); TRRD2(h1, b_ + 6144); TRRD2(l2, b_ + 8192); TRRD2(h2, b_ + 10240); TRRD2(l3, b_ + 12288); TRRD2(h3, b_ + 14336); \
        asm volatile("s_waitcnt lgkmcnt(0)" ::: "memory"); SBAR2();   \
        o[(hv) * 4 + (d0)] = __builtin_amdgcn_mfma_f32_32x32x16_bf16(pa0, (bf16x8){l0[0], l0[1], l0[2], l0[3], h0[0], h0[1], h0[2], h0[3]}, o[(hv) * 4 + (d0)], 0, 0, 0);   \
        o[(hv) * 4 + (d0)] = __builtin_amdgcn_mfma_f32_32x32x16_bf16(pa1, (bf16x8){l1[0], l1[1], l1[2], l1[3], h1[0], h1[1], h1[2], h1[3]}, o[(hv) * 4 + (d0)], 0, 0, 0);   \
        o[(hv) * 4 + (d0)] = __builtin_amdgcn_mfma_f32_32x32x16_bf16(pa2, (bf16x8){l2[0], l2[1], l2[2], l2[3], h2[0], h2[1], h2[2], h2[3]}, o[(hv) * 4 + (d0)], 0, 0, 0);   \
        o[(hv) * 4 + (d0)] = __builtin_amdgcn_mfma_f32_32x32x16_bf16(pa3, (bf16x8){l3[0], l3[1], l3[2], l3[3], h3[0], h3[1], h3[2], h3[3]}, o[(hv) * 4 + (d0)], 0, 0, 0); } while (0)
    PV2_D0(0, 0); PV2_D0(0, 1); PV2_D0(0, 2); PV2_D0(0, 3); PV2_D0(1, 0); PV2_D0(1, 1); PV2_D0(1, 2); PV2_D0(1, 3);
#undef PV2_D0
#undef TRRD2
}
struct DRef { const bf16* Q; const bf16* K; const bf16* V0; const bf16* V1; bf16* O; int P0, opitch; const bf16* O1; bf16* Y; const float* lamp; const float* subln; int desc; };
__device__ __forceinline__ void diff_block(const DRef& R, char* lds, PG8_LAS unsigned char* ldsL, float* xl) {
    int tid_l = threadIdx.x; asm volatile("" : "+v"(tid_l)); const int tid = tid_l, wid = __builtin_amdgcn_readfirstlane(tid >> 6), lane = tid & 63, r32 = lane & 31, hi = lane >> 5;
    const bool prod = wid < 4; const int pw = wid & 3;
    const int NT = R.P0 / KVBLK + ROWS / KVBLK;
    const int tix0 = R.desc ? NT - 1 : 0, tixd = R.desc ? -1 : 1;
#define TIX(t) (tix0 + tixd * (t))
    char* K_lds = lds + OFF_K; char* V_lds = lds + OFF_V; char* P_lds = lds + OFF_P;
    float* AL = xl; float* LL = xl + 256; float* AF = xl + 384;
    const int vb0 = (int)(uintptr_t)V_lds + v_rd_base(lane);
    unsigned kgo[2], vgo[4];
#pragma unroll
    for (int i = 0; i < 2; ++i) { const int row = wid * 8 + i * 4 + (lane >> 4); kgo[i] = (unsigned)(row * D + (((lane & 15) ^ (row & 7)) * 8)) * 2u; }
#pragma unroll
    for (int i = 0; i < 4; ++i) { const int blk = ((wid & 3) * 4 + i) * 2 + (lane >> 5), kk = ((blk >> 2) << 3) | ((lane & 31) >> 2), k = (kk & ~0xC) | ((kk & 4) << 1) | ((kk & 8) >> 1);
        vgo[i] = (unsigned)(k * D + (blk & 3) * 32 + (lane & 3) * 8) * 2u; }
    const bf16* Vh; { const unsigned long long v_ = (unsigned long long)(uintptr_t)(wid < 4 ? R.V0 : R.V1);
      Vh = (const bf16*)(uintptr_t)(((unsigned long long)(unsigned)__builtin_amdgcn_readfirstlane((int)(v_ >> 32)) << 32) | (unsigned)__builtin_amdgcn_readfirstlane((int)v_)); }
#define DMA_K(t, buf) do { const char* g_ = (const char*)(R.K + (size_t)TIX(t) * KVBLK * D); _Pragma("unroll") for (int i_ = 0; i_ < 2; ++i_)                                             \
        __builtin_amdgcn_global_load_lds((const unsigned*)(g_ + kgo[i_]), (PG8_LAS unsigned*)(ldsL + OFF_K + (buf) * SHM_K2 + (wid * 2 + i_) * 1024), 16, 0, 0); } while (0)
#define DMA_V(t, buf) do { const char* g_ = (const char*)(Vh + (size_t)TIX(t) * KVBLK * D); _Pragma("unroll") for (int i_ = 0; i_ < 4; ++i_)                                               \
        __builtin_amdgcn_global_load_lds((const unsigned*)(g_ + vgo[i_]), (PG8_LAS unsigned*)(ldsL + OFF_V + (buf) * SHM_V2 + (wid >> 2) * 16384 + ((wid & 3) * 4 + i_) * 1024), 16, 0, 0); } while (0)
#define STAGE(t, PB) do { if ((t) + 1 < NT) DMA_K((t) + 1, 1 - (PB)); DMA_V(t, PB); SBAR2(); } while (0)
#define DMA_PIECE(i, t, PB) do { if ((i) < 2) { if ((t) + 1 < NT) { const char* g_ = (const char*)(R.K + (size_t)TIX((t) + 1) * KVBLK * D);                                                   \
            __builtin_amdgcn_global_load_lds((const unsigned*)(g_ + kgo[(i) & 1]), (PG8_LAS unsigned*)(ldsL + OFF_K + (1 - (PB)) * SHM_K2 + (wid * 2 + ((i) & 1)) * 1024), 16, 0, 0); } }         \
        else { const char* g_ = (const char*)(Vh + (size_t)TIX(t) * KVBLK * D);                                                                                                                  \
            __builtin_amdgcn_global_load_lds((const unsigned*)(g_ + vgo[((i) - 2) & 3]), (PG8_LAS unsigned*)(ldsL + OFF_V + (PB) * SHM_V2 + (wid >> 2) * 16384 + ((wid & 3) * 4 + (((i) - 2) & 3)) * 1024), 16, 0, 0); } } while (0)
#define ENDSTEP() do { asm volatile("s_waitcnt vmcnt(0)" ::: "memory"); __syncthreads(); } while (0)
    if (prod) {
        bf16x8 qr[8]; float m_reg = -1e30f, l_reg = 0.f;
        const int qlo = R.P0 + pw * QBLK, qlo_m = qlo | 63, qm = ((qlo + r32) | 63) - 4 * hi;
        DMA_K(0, 0);
#pragma unroll
        for (int d0 = 0; d0 < 8; ++d0) qr[d0] = load8(R.Q + (size_t)(pw * QBLK + r32) * D + d0 * 16 + hi * 8);
        ENDSTEP();
        const char* kq0 = K_lds + KSWZ2(r32, (0 * 16 + hi * 8) * 2); const char* kq1 = K_lds + KSWZ2(r32, (1 * 16 + hi * 8) * 2);
        const char* kq2 = K_lds + KSWZ2(r32, (2 * 16 + hi * 8) * 2); const char* kq3 = K_lds + KSWZ2(r32, (3 * 16 + hi * 8) * 2);
#define QK_D0(KB, d0) do { const char* a_ = (((d0) & 3) == 0 ? kq0 : ((d0) & 3) == 1 ? kq1 : ((d0) & 3) == 2 ? kq2 : kq3) + (KB) * SHM_K2 + ((d0) >> 2) * 128;   \
            const bf16x8 b0_ = *reinterpret_cast<const bf16x8*>(a_), b1_ = *reinterpret_cast<const bf16x8*>(a_ + 32 * 256);                                    \
            p0 = __builtin_amdgcn_mfma_f32_32x32x16_bf16(b0_, qr[d0], p0, 0, 0, 0); p1 = __builtin_amdgcn_mfma_f32_32x32x16_bf16(b1_, qr[d0], p1, 0, 0, 0); } while (0)
#define PROD_STEP(t, PB) do { f32x16 p0, p1; float mn, al; bf16x8 pa0, pa1, pa2, pa3;                                             \
            p0 = f32x16{}; p1 = f32x16{};                                                                                          \
            QK_D0(PB, 0); QK_D0(PB, 1); DMA_PIECE(0, t, PB); QK_D0(PB, 2); DMA_PIECE(1, t, PB); QK_D0(PB, 3); DMA_PIECE(2, t, PB); QK_D0(PB, 4); DMA_PIECE(3, t, PB); \
            QK_D0(PB, 5); DMA_PIECE(4, t, PB); QK_D0(PB, 6); DMA_PIECE(5, t, PB); QK_D0(PB, 7);                                    \
            { const int kb_ = TIX(t) * KVBLK; if (kb_ + KVBLK - 1 > qlo_m) mask_tile(p0, p1, qm - kb_, WINF); }                   \
            partialSM(p0, p1, m_reg, mn, al); finishSM(p0, p1, al, l_reg, pa0, pa1, pa2, pa3);                                    \
            char* pp_ = P_lds + (PB) * SHM_P2 + pw * 4096 + lane * 16;                                                            \
            *(bf16x8*)(pp_) = pa0; *(bf16x8*)(pp_ + 1024) = pa1; *(bf16x8*)(pp_ + 2048) = pa2; *(bf16x8*)(pp_ + 3072) = pa3;       \
            if (hi == 0) AL[(PB) * 128 + pw * 32 + r32] = al;                                                                     \
            { const bool f_ = __any(al < 1.f); if (lane == 0) AF[(PB) * 4 + pw] = f_ ? 1.f : 0.f; } } while (0)
        for (int t = 0; t < NT; t += 2) { PROD_STEP(t, 0); ENDSTEP(); PROD_STEP(t + 1, 1); ENDSTEP(); }
        if (hi == 0) LL[pw * 32 + r32] = l_reg;
        __syncthreads();
        __syncthreads();
        __syncthreads();
#undef PROD_STEP
#undef QK_D0
    } else {
        f32x16 o[8] = {};
        const int vbq = vb0 + (pw >> 1) * 16384 + (pw & 1) * 1024;
        DMA_K(0, 0);
        ENDSTEP();
#define TRRDQ(dst, off) asm volatile("ds_read_b64_tr_b16 %0, %1 offset:%2" : "=&v"(dst) : "v"(vbq), "i"(off) : "memory")
#define CONS_STEP(PBP  , DMAON, t, PB  ) do {                       \
            s16x4 l_[2][4], h_[2][4];                                                                                              \
            _Pragma("unroll") for (int cb = 0; cb < 2; ++cb) { TRRDQ(l_[cb][0], (PBP) * SHM_V2 + cb * 512); TRRDQ(h_[cb][0], (PBP) * SHM_V2 + cb * 512 + 2048);                 \
                TRRDQ(l_[cb][1], (PBP) * SHM_V2 + cb * 512 + 4096); TRRDQ(h_[cb][1], (PBP) * SHM_V2 + cb * 512 + 6144);                                                          \
                TRRDQ(l_[cb][2], (PBP) * SHM_V2 + cb * 512 + 8192); TRRDQ(h_[cb][2], (PBP) * SHM_V2 + cb * 512 + 10240);                                                         \
                TRRDQ(l_[cb][3], (PBP) * SHM_V2 + cb * 512 + 12288); TRRDQ(h_[cb][3], (PBP) * SHM_V2 + cb * 512 + 14336); }                                                      \
            asm volatile("s_waitcnt lgkmcnt(0)" ::: "memory"); SBAR2();                                                            \
            _Pragma("unroll") for (int rb = 0; rb < 4; ++rb) {                                                                      \
                if (__builtin_amdgcn_readfirstlane(__builtin_bit_cast(int, AF[(PBP) * 4 + rb])) != 0) { const float* al_ = AL + (PBP) * 128 + rb * 32;                                      \
                    _Pragma("unroll") for (int r = 0; r < 16; ++r) { const float a_ = al_[crow(r, hi)]; o[2 * rb][r] *= a_; o[2 * rb + 1][r] *= a_; } }   \
                const char* pp_ = P_lds + (PBP) * SHM_P2 + rb * 4096 + lane * 16;                                                   \
                const bf16x8 pa0 = *(const bf16x8*)(pp_), pa1 = *(const bf16x8*)(pp_ + 1024), pa2 = *(const bf16x8*)(pp_ + 2048), pa3 = *(const bf16x8*)(pp_ + 3072); \
                _Pragma("unroll") for (int cb = 0; cb < 2; ++cb) {                                                                  \
                    o[2 * rb + cb] = __builtin_amdgcn_mfma_f32_32x32x16_bf16(pa0, (bf16x8){l_[cb][0][0], l_[cb][0][1], l_[cb][0][2], l_[cb][0][3], h_[cb][0][0], h_[cb][0][1], h_[cb][0][2], h_[cb][0][3]}, o[2 * rb + cb], 0, 0, 0); \
                    o[2 * rb + cb] = __builtin_amdgcn_mfma_f32_32x32x16_bf16(pa1, (bf16x8){l_[cb][1][0], l_[cb][1][1], l_[cb][1][2], l_[cb][1][3], h_[cb][1][0], h_[cb][1][1], h_[cb][1][2], h_[cb][1][3]}, o[2 * rb + cb], 0, 0, 0); \
                    o[2 * rb + cb] = __builtin_amdgcn_mfma_f32_32x32x16_bf16(pa2, (bf16x8){l_[cb][2][0], l_[cb][2][1], l_[cb][2][2], l_[cb][2][3], h_[cb][2][0], h_[cb][2][1], h_[cb][2][2], h_[cb][2][3]}, o[2 * rb + cb], 0, 0, 0); \
                    o[2 * rb + cb] = __builtin_amdgcn_mfma_f32_32x32x16_bf16(pa3, (bf16x8){l_[cb][3][0], l_[cb][3][1], l_[cb][3][2], l_[cb][3][3], h_[cb][3][0], h_[cb][3][1], h_[cb][3][2], h_[cb][3][3]}, o[2 * rb + cb], 0, 0, 0); } \
                if (DMAON) { if (rb == 0) { DMA_PIECE(0, t, PB); DMA_PIECE(1, t, PB); } else if (rb == 1) { DMA_PIECE(2, t, PB); DMA_PIECE(3, t, PB); } else if (rb == 2) DMA_PIECE(4, t, PB); else DMA_PIECE(5, t, PB); } } } while (0)
        STAGE(0, 0); ENDSTEP(); CONS_STEP(0, 1, 1, 1); ENDSTEP();
        for (int t = 2; t < NT; t += 2) { CONS_STEP(1, 1, t, 0); ENDSTEP(); CONS_STEP(0, 1, t + 1, 1); ENDSTEP(); }
        CONS_STEP(1, 0, 0, 0);
        __syncthreads();
        if (R.O1 == nullptr) {
#pragma unroll
            for (int rb = 0; rb < 4; ++rb)
#pragma unroll
                for (int r = 0; r < 16; ++r) { const int orow = rb * 32 + crow(r, hi); const float rl = __builtin_amdgcn_rcpf(LL[orow]);
#pragma unroll
                    for (int cb = 0; cb < 2; ++cb) { const float v = o[2 * rb + cb][r] * rl; const float vn = __shfl_xor(v, 1);
                        if ((r32 & 1) == 0) *(unsigned*)(R.O + (size_t)orow * R.opitch + 64 * pw + cb * 32 + r32) = cvtpk(v, vn); } }
            __syncthreads();
        } else {
            const bf16* O1w = R.O1 + (size_t)(pw * QBLK) * R.opitch + 4 * lane; bf16* Yw = R.Y + (size_t)(pw * QBLK) * 2048 + 4 * lane;
            unsigned long long a1[32];
#pragma unroll
            for (int rr = 0; rr < 32; ++rr) a1[rr] = *(const unsigned long long*)(O1w + (size_t)rr * R.opitch);
            float* park = (float*)lds;
#pragma unroll
            for (int rb = 0; rb < 4; ++rb)
#pragma unroll
                for (int r = 0; r < 16; ++r) { const int orow = rb * 32 + crow(r, hi); const float rl = __builtin_amdgcn_rcpf(LL[orow]);
#pragma unroll
                    for (int cb = 0; cb < 2; ++cb) park[orow * 256 + 64 * pw + cb * 32 + r32] = o[2 * rb + cb][r] * rl; }
            __syncthreads();
            float s1 = R.lamp[lane] * R.lamp[128 + lane] + R.lamp[64 + lane] * R.lamp[192 + lane], s2 = R.lamp[256 + lane] * R.lamp[384 + lane] + R.lamp[320 + lane] * R.lamp[448 + lane];
#pragma unroll
            for (int of = 1; of < 64; of <<= 1) { s1 += __shfl_xor(s1, of); s2 += __shfl_xor(s2, of); }
            const float lam = __expf(s1) - __expf(s2) + 0.2f;
            const f32x4 gs = *(const f32x4*)(R.subln + 4 * lane) * 0.8f;
            const float* prow = park + (size_t)(pw * QBLK) * 256 + 4 * lane;
#pragma unroll
            for (int rr = 0; rr < 32; ++rr) { const unsigned long long a = a1[rr]; const f32x4 o2 = *(const f32x4*)(prow + rr * 256);
                f32x4 y;
                y.x = __builtin_bit_cast(float, (unsigned)(a << 16)) - lam * o2.x; y.y = __builtin_bit_cast(float, (unsigned)a & 0xffff0000u) - lam * o2.y;
                y.z = __builtin_bit_cast(float, (unsigned)(a >> 32) << 16) - lam * o2.z; y.w = __builtin_bit_cast(float, (unsigned)(a >> 32) & 0xffff0000u) - lam * o2.w;
                float ss = (y.x * y.x + y.y * y.y) + (y.z * y.z + y.w * y.w);
#pragma unroll
                for (int of = 1; of < 64; of <<= 1) ss += __shfl_xor(ss, of);
                const float rs = 1.f / sqrtf(ss * (1.f / 256.f) + 1e-6f);
                y = y * rs * gs;
                *(unsigned long long*)(Yw + (size_t)rr * 2048) = (unsigned long long)cvtpk(y.x, y.y) | ((unsigned long long)cvtpk(y.z, y.w) << 32); } }
        __syncthreads();
#undef CONS_STEP
#undef TRRDQ
    }
#undef STAGE
#undef DMA_PIECE
#undef ENDSTEP
#undef DMA_K
#undef DMA_V
#undef TIX
#undef LD_K
#undef LD_V
#undef ST_K
#undef ST_V
}
#undef KSWZ2
#undef SBAR2
}
#define GAS __attribute__((address_space(1)))
#define LAS __attribute__((address_space(3)))
typedef unsigned short bf16;
typedef unsigned v4u __attribute__((ext_vector_type(4)));
typedef float f32x4 __attribute__((ext_vector_type(4)));
typedef short bf16x8 __attribute__((ext_vector_type(8)));
typedef GAS unsigned gu32;
typedef GAS unsigned long long gu64;
#define RLX_AGENT __ATOMIC_RELAXED, __HIP_MEMORY_SCOPE_AGENT
#define LDS_WAIT() asm volatile("s_waitcnt lgkmcnt(0)" ::: "memory")
#define VM_WAIT() asm volatile("s_waitcnt vmcnt(0)" ::: "memory")
__device__ __forceinline__ unsigned long long rt() { return __builtin_amdgcn_s_memrealtime(); }
__device__ __forceinline__ unsigned f2bf(float f) { unsigned u = __builtin_bit_cast(unsigned, f); return (u + 0x7fffu + ((u >> 16) & 1u)) >> 16; }
__device__ __forceinline__ unsigned pk2(float lo, float hi) { return f2bf(lo) | (f2bf(hi) << 16); }
#define XB_TMO      128
#define XB_XCNT(j)  (256  + 64 * (j))
#define XB_XSUB(j)  (1280 + 64 * (j))
#define XB_XGEN(j)  (2304 + 64 * (j))
#define XB_TOP      3328
#define XB_TOPGEN   3392
#define XCD_BAR_WORDS 3456
#define XB_SPIN_CAP (1u << 18)

__device__ __forceinline__ unsigned xb_ld(unsigned* p)              { return __hip_atomic_load(p, __ATOMIC_RELAXED, __HIP_MEMORY_SCOPE_AGENT); }
__device__ __forceinline__ unsigned xb_add(unsigned* p, unsigned v) { return __hip_atomic_fetch_add(p, v, __ATOMIC_RELAXED, __HIP_MEMORY_SCOPE_AGENT); }
__device__ __forceinline__ unsigned xb_xcc_id() { return (unsigned)__builtin_amdgcn_s_getreg((3 << 11) | 20) & 0xFu; }
#define XB_SPIN(cond, bar) do { unsigned _sp = 0; while (cond) { __builtin_amdgcn_s_sleep(1); \
    if ((++_sp & 255u) == 0u) { if (xb_ld(&(bar)[XB_TMO])) break; if (_sp > XB_SPIN_CAP) { atomicAdd(&(bar)[XB_TMO], 1u); break; } } } } while (0)

struct XcdBarrier {
    unsigned* bar; unsigned x;
    volatile LAS unsigned* st;
};

__device__ __forceinline__ XcdBarrier xcd_barrier_post(unsigned* bar, volatile LAS unsigned* st) {
    XcdBarrier b; b.bar = bar; b.x = xb_xcc_id(); b.st = st;
    if (threadIdx.x == 0) (void)xb_add(&bar[XB_XCNT(b.x)], 1u);
    return b;
}
__device__ __forceinline__ void xcd_barrier_complete(unsigned* bar, unsigned x, unsigned& nloc, unsigned& nx) {
    const unsigned G = gridDim.x * gridDim.y * gridDim.z;
    unsigned sum, cnt, mine, sp = 0u;
    for (;;) {
        sum = 0u; cnt = 0u; mine = 0u;
#pragma unroll
        for (unsigned j = 0; j < 16; ++j) { const unsigned c = xb_ld(&bar[XB_XCNT(j)]); sum += c; cnt += (c > 0u) ? 1u : 0u; mine = (j == x) ? c : mine; }
        if (sum == G) break;
        __builtin_amdgcn_s_sleep(1);
        if ((++sp & 255u) == 0u) { if (xb_ld(&bar[XB_TMO])) break; if (sp > XB_SPIN_CAP) { atomicAdd(&bar[XB_TMO], 1u); break; } }
    }
    nloc = mine > 0u ? mine : 1u; nx = cnt > 0u ? cnt : 1u;
}

__device__ __forceinline__ void xcd_barrier(const XcdBarrier& b) {
    asm volatile("s_waitcnt vmcnt(0)" ::: "memory");
    __syncthreads();
    if (threadIdx.x == 0) {
        unsigned* bar = b.bar;
        __builtin_amdgcn_s_waitcnt(0);
        unsigned nloc = b.st[0], nx = b.st[1];
        if (nloc == 0u) { xcd_barrier_complete(bar, b.x, nloc, nx); b.st[0] = nloc; b.st[1] = nx; }
        const unsigned old = xb_add(&bar[XB_XSUB(b.x)], 1u);
        const unsigned gen = old / nloc;
        if (old + 1u == (gen + 1u) * nloc) {
            __builtin_amdgcn_fence(__ATOMIC_RELEASE, "agent");
            asm volatile("s_waitcnt vmcnt(0)" ::: "memory");
            const unsigned og = xb_add(&bar[XB_TOP], 1u);
            const unsigned tg = og / nx;
            if (og + 1u == (tg + 1u) * nx) xb_add(&bar[XB_TOPGEN], 1u);
            else XB_SPIN(xb_ld(&bar[XB_TOPGEN]) == tg, bar);
            __builtin_amdgcn_fence(__ATOMIC_ACQUIRE, "agent");
            xb_add(&bar[XB_XGEN(b.x)], 1u);
            asm volatile("s_waitcnt vmcnt(0)" ::: "memory");
        } else {
            XB_SPIN(xb_ld(&bar[XB_XGEN(b.x)]) == gen, bar);
            __builtin_amdgcn_fence(__ATOMIC_ACQUIRE, "agent");
            asm volatile("s_waitcnt vmcnt(0)" ::: "memory");
        }
    }
    __syncthreads();
}
__device__ __forceinline__ float wave_sum(float v) {
#pragma unroll
    for (int o = 1; o < 64; o <<= 1) v += __shfl_xor(v, o);
    return v;
}
constexpr int NWAVES = 8;
#ifndef ST_FFN1
#define ST_FFN1 1
#endif
#ifndef ST_MIX
#define ST_MIX 1
#endif
#ifndef ST_FFN2
#define ST_FFN2 1
#endif
#ifndef ST_ATT
#define ST_ATT 1
#endif
#ifndef ST_MA
#define ST_MA 1
#endif
#ifndef ST_P5
#define ST_P5 1
#endif
#ifndef ST_FF
#define ST_FF 1
#endif
constexpr int BATCH = 4, SEQ = 4096, DM = 4096, M = BATCH * SEQ, DFF = 11008, NFF2 = 2 * DFF;
constexpr int INCOLS = 20496, NPROJ = 20480;
constexpr int NADA = 9 * DM, NFADA = 2 * DM, NMODC = NADA + NFADA;
constexpr int KCH = 32, KCHR = DM / KCH;
constexpr float RMS_EPS = 1e-6f;
constexpr size_t MiB = 1u << 20;
constexpr size_t WS_CTL = 0, CTL_ZERO_BYTES = 1 * MiB;
constexpr size_t WS_MODV = 1 * MiB;
constexpr size_t WS_ROPEC = 2 * MiB, WS_ROPES = 3 * MiB;
constexpr size_t WS_KBIAS = 4 * MiB;
constexpr size_t WS_LOGF = 5 * MiB;
constexpr size_t WS_WFF = 6 * MiB;
constexpr size_t WS_PART = 8 * MiB;
constexpr size_t WS_W1IN = 30 * MiB, WS_W1OUT = 202 * MiB, WS_W2IN = 288 * MiB, WS_W2OUT = 460 * MiB, WS_WIN = 546 * MiB, WS_WOFOX = 706 * MiB, WS_WODIFF = 722 * MiB, WS_WOUT = 738 * MiB;
constexpr size_t WS_HB = 770 * MiB;
constexpr size_t WS_BIG = 898 * MiB;
constexpr size_t WS_QKV = WS_BIG, WS_GATES = WS_BIG + 384 * MiB;
constexpr size_t WS_YA = 1538 * MiB;
constexpr size_t WS_ODIFF = 1602 * MiB;
constexpr size_t WS_YB = 1730 * MiB;
constexpr size_t WS_TMP = 1794 * MiB;
constexpr size_t WS_XS = 1922 * MiB;
constexpr size_t WS_END = 2050 * MiB;
static_assert(WS_PART + (size_t)KCH * 4 * NMODC * 4 <= WS_W1IN && WS_W1IN + (size_t)NFF2 * DM * 2 <= WS_W1OUT && WS_W1OUT + (size_t)DM * DFF * 2 <= WS_W2IN && WS_WIN + (size_t)NPROJ * DM * 2 <= WS_WOFOX &&
              WS_BIG + (size_t)M * DFF * 2 <= WS_YA && WS_GATES + (size_t)M * 8192 * 2 <= WS_YA, "d_ws map");
constexpr int CW_BAR = 4096;
constexpr size_t WS_NRM = 768 * 1024;
constexpr int RING_OFF = 0, RING_BYTES = 131072;
constexpr int LDSCTL_OFF = RING_BYTES, MISC_OFF = LDSCTL_OFF + 320;
constexpr int LDS_BYTES = 147456;
constexpr int ATT2_XL_OFF = LDSCTL_OFF + 1024;
static_assert(MISC_OFF + 128 <= LDS_BYTES && att::LDS_BYTES <= RING_BYTES, "LDS map");

template <class Map>
__device__ __forceinline__ void p0_transpose_item(const float* W, int K, int N, const Map& mp, LAS float* scr, int item, int lane) {
    const int nblk = (N + 31) / 32, kb = item / nblk, nb = item % nblk, k0 = 64 * kb, n0 = 32 * nb;
    const bool okc = n0 + (lane & 31) < N;
    float wv[32];
#pragma unroll
    for (int i = 0; i < 32; ++i) { const int kk = 2 * i + (lane >> 5); wv[i] = okc ? W[(size_t)(k0 + kk) * N + n0 + (lane & 31)] : 0.f; }
#pragma unroll
    for (int i = 0; i < 32; ++i) { const int kk = 2 * i + (lane >> 5); scr[kk * 33 + (lane & 31)] = wv[i]; }
    LDS_WAIT(); asm volatile("" ::: "memory");
    const int c = lane & 7;
#pragma unroll
    for (int j = 0; j < 4; ++j) { const int n = (lane >> 3) + 8 * j; const LAS float* s = scr + (8 * c) * 33 + n;
        v4u o; o.x = pk2(s[0 * 33], s[1 * 33]); o.y = pk2(s[2 * 33], s[3 * 33]); o.z = pk2(s[4 * 33], s[5 * 33]); o.w = pk2(s[6 * 33], s[7 * 33]);
        bf16* dst = (n0 + n < N) ? mp(n0 + n) : nullptr;
        if (dst) *(GAS v4u*)(dst + k0 + 8 * c) = o; }
    LDS_WAIT(); asm volatile("" ::: "memory");
}
struct MapId { bf16* WT; int K; __device__ __forceinline__ bf16* operator()(int n) const { return WT + (size_t)n * K; } };
struct MapGlu { bf16* WT; __device__ __forceinline__ bf16* operator()(int n) const { const int up = n >= DFF, j = n - up * DFF; return WT + (size_t)((j >> 7) * 256 + up * 128 + (j & 127)) * DM; } };
struct MapWin { bf16* WT; bf16* WFF; __device__ __forceinline__ bf16* operator()(int n) const {
    if (n >= 6144 && n < 6160) return WFF + (size_t)(n - 6144) * DM;
    int r = n < 6144 ? n : n - 16;
    if (r >= 6144 && r < 10240) { const int a = r & 127; if (a < 32) { const int a2 = a & 15; r = (r & ~127) + 8 * (a2 >> 2) + 4 * (a >> 4) + (a2 & 3); } }
    return WT + (size_t)r * DM; } };

__device__ __forceinline__ void gemv_task(const float* W, int N, const float* cvec, float* part, int ncol_off, int task, LAS float* scs, int lane) {
    const int nstrips = N / 256, kc = task / nstrips, strip = task % nstrips, n = strip * 256 + lane * 4, k0 = kc * KCHR;
#pragma unroll
    for (int j = 0; j < KCHR / 64; ++j) { const int kk = lane + 64 * j;
#pragma unroll
        for (int b = 0; b < 4; ++b) { const float x = cvec[b * DM + k0 + kk]; scs[kk * 4 + b] = x / (1.f + __expf(-x)); } }
    LDS_WAIT(); asm volatile("" ::: "memory");
    f32x4 a0 = {0.f, 0.f, 0.f, 0.f}, a1 = a0, a2 = a0, a3 = a0;
    const float* wp = W + (size_t)k0 * N + n;
#pragma unroll 8
    for (int kk = 0; kk < KCHR; ++kk) { const f32x4 w = *(const GAS f32x4*)(wp + (size_t)kk * N); const f32x4 s4 = *(const LAS f32x4*)(scs + kk * 4);
        a0 += s4[0] * w; a1 += s4[1] * w; a2 += s4[2] * w; a3 += s4[3] * w; }
    float* pp = part + (size_t)(kc * 4) * NMODC + ncol_off + n;
    *(GAS f32x4*)(pp) = a0; *(GAS f32x4*)(pp + NMODC) = a1; *(GAS f32x4*)(pp + 2 * NMODC) = a2; *(GAS f32x4*)(pp + 3 * NMODC) = a3;
    LDS_WAIT(); asm volatile("" ::: "memory");
}
__constant__ float c_inv_freq[16] = {1.000000000e+00f, 4.403665960e-01f, 1.939227432e-01f, 8.539710194e-02f, 3.760603070e-02f, 1.656043902e-02f, 7.292664610e-03f, 3.211445874e-03f,
                                     1.414213562e-03f, 6.227723788e-04f, 2.742481884e-04f, 1.207697351e-04f, 5.318296098e-05f, 2.341999971e-05f, 1.031338616e-05f, 4.541670478e-06f};
__device__ __forceinline__ void sincos_f64(float angf, float& c, float& s) {
    const double a = (double)angf; const double kq = __builtin_rint(a * 0.63661977236758134308);
    const double r = (a - kq * 1.57079632679489655800e+00) - kq * 6.12323399573676603587e-17; const double r2 = r * r;
    const double sp = r * (1.0 + r2 * (-1.66666666666666324348e-01 + r2 * (8.33333333332248946124e-03 + r2 * (-1.98412698298579493134e-04 + r2 * (2.75573137070700676789e-06 + r2 * (-2.50507602534068634195e-08 + r2 * 1.58969099521155010221e-10))))));
    const double cp = 1.0 + r2 * (-0.5 + r2 * (4.16666666666666019037e-02 + r2 * (-1.38888888888741095749e-03 + r2 * (2.48015872894767294178e-05 + r2 * (-2.75573143513906633035e-07 + r2 * (2.08757232129817482790e-09 + r2 * -1.13596475577881948265e-11))))));
    const int q = (int)((long long)kq & 3);
    const double sv = (q & 1) ? cp : sp, cv = (q & 1) ? sp : cp;
    s = (float)((q & 2) ? -sv : sv); c = (float)(((q + 1) & 2) ? -cv : cv);
}

template <bool OUT_F32, bool IN_BF16>
__device__ __forceinline__ void norm_phase(const void* X, void* OUT, const float* Avec, const float* SHvec, LAS unsigned char* lds, int vcu, int G, int tid, int wave, int lane, bool poison) {
    LAS f32x4* LA = (LAS f32x4*)lds; LAS f32x4* LS = (LAS f32x4*)(lds + 16384);
    for (int panel = vcu; panel < M / 64; panel += G) { const int b = panel >> 6;
        for (int i = tid; i < 1024; i += NWAVES * 64) { LA[i] = *(const GAS f32x4*)(Avec + b * DM + 4 * i); LS[i] = *(const GAS f32x4*)(SHvec + b * DM + 4 * i); }
        __syncthreads();
        for (int rr = 0; rr < 8; ++rr) { const int row = panel * 64 + wave * 8 + rr;
            f32x4 v[16]; float ss = 0.f;
            if (IN_BF16) { const GAS v4u* xr = (const GAS v4u*)((const bf16*)X + (size_t)row * DM) + lane;
#pragma unroll
                for (int j = 0; j < 8; ++j) { const v4u w = xr[64 * j];
                    v[2 * j] = (f32x4){__builtin_bit_cast(float, w.x << 16), __builtin_bit_cast(float, w.x & 0xffff0000u), __builtin_bit_cast(float, w.y << 16), __builtin_bit_cast(float, w.y & 0xffff0000u)};
                    v[2 * j + 1] = (f32x4){__builtin_bit_cast(float, w.z << 16), __builtin_bit_cast(float, w.z & 0xffff0000u), __builtin_bit_cast(float, w.w << 16), __builtin_bit_cast(float, w.w & 0xffff0000u)}; } }
            else { const GAS f32x4* xr = (const GAS f32x4*)((const float*)X + (size_t)row * DM) + lane;
#pragma unroll
                for (int j = 0; j < 16; ++j) v[j] = xr[64 * j]; }
#pragma unroll
            for (int j = 0; j < 16; ++j) ss += (v[j].x * v[j].x + v[j].y * v[j].y) + (v[j].z * v[j].z + v[j].w * v[j].w);
            float r = 1.f / sqrtf(wave_sum(ss) * (1.f / DM) + RMS_EPS); if (poison) r = __builtin_nanf("");
#pragma unroll
            for (int j = 0; j < 16; ++j) { const int ci = IN_BF16 ? 2 * (lane + 64 * (j >> 1)) + (j & 1) : lane + 64 * j;
                const f32x4 y = v[j] * r * LA[ci] + LS[ci];
                if (OUT_F32) ((GAS f32x4*)((float*)OUT + (size_t)row * DM))[ci] = y;
                else ((GAS unsigned long long*)((bf16*)OUT + (size_t)row * DM))[ci] = (unsigned long long)pk2(y.x, y.y) | ((unsigned long long)pk2(y.z, y.w) << 32); } }
        __syncthreads(); }
}

__device__ __forceinline__ void ff_phase(const bf16* H, const bf16* Wff, const float* bfg, float* logf, int vcu, int G, int wave, int lane) {
    const int fr = lane & 15, fq = lane >> 4;
    for (int t = wave * G + vcu; t < M / 16; t += NWAVES * G) { const int row0 = t * 16; f32x4 acc = {0.f, 0.f, 0.f, 0.f};
        const bf16* ap = H + (size_t)(row0 + fr) * DM + 8 * fq; const bf16* wp = Wff + (size_t)fr * DM + 8 * fq;
#pragma unroll 8
        for (int ks = 0; ks < DM / 32; ++ks) { const bf16x8 a = *(const GAS bf16x8*)(ap + 32 * ks), w = *(const GAS bf16x8*)(wp + 32 * ks); acc = __builtin_amdgcn_mfma_f32_16x16x32_bf16(w, a, acc, 0, 0, 0); }
        const int b = row0 >> 12, s = (row0 & 4095) + fr;
#pragma unroll
        for (int j = 0; j < 4; ++j) { const int h = 4 * fq + j; const float z = acc[j] + bfg[h]; const float ls = fminf(z, 0.f) - log1pf(__expf(-fabsf(z))); logf[(size_t)(b * 16 + h) * SEQ + s] = ls; } }
}
__device__ __forceinline__ void cumsum_phase(const float* logf, float* kbias, LAS unsigned char* lds, int vcu, int G, int tid, int wave, int lane) {
    LAS float* wt = (LAS float*)lds;
    for (int bh = vcu; bh < 64; bh += G) {
        const f32x4 x0 = *(const GAS f32x4*)(logf + (size_t)bh * SEQ + tid * 8), x1 = *(const GAS f32x4*)(logf + (size_t)bh * SEQ + tid * 8 + 4);
        float p[8]; p[0] = x0.x; p[1] = p[0] + x0.y; p[2] = p[1] + x0.z; p[3] = p[2] + x0.w; p[4] = p[3] + x1.x; p[5] = p[4] + x1.y; p[6] = p[5] + x1.z; p[7] = p[6] + x1.w;
        float sc = p[7];
#pragma unroll
        for (int o = 1; o < 64; o <<= 1) { const float t = __shfl_up(sc, o); if (lane >= o) sc += t; }
        if (lane == 63) wt[wave] = sc;
        __syncthreads();
        float base = sc - p[7];
        for (int w = 0; w < wave; ++w) base += wt[w];
        const float k = -11.313708498984761f;
        f32x4 o0, o1; o0.x = (base + p[0]) * k; o0.y = (base + p[1]) * k; o0.z = (base + p[2]) * k; o0.w = (base + p[3]) * k; o1.x = (base + p[4]) * k; o1.y = (base + p[5]) * k; o1.z = (base + p[6]) * k; o1.w = (base + p[7]) * k;
        *(GAS f32x4*)(kbias + (size_t)bh * SEQ + tid * 8) = o0; *(GAS f32x4*)(kbias + (size_t)bh * SEQ + tid * 8 + 4) = o1;
        __syncthreads(); }
}
__device__ __forceinline__ void qknorm_phase(const bf16* FQ, const bf16* FK, unsigned* nrm, int vcu, int G, int wave, int lane) {
    for (int work = vcu; work < 256; work += G) { const int bh = work >> 2, part = work & 3;
        const bf16* qp = FQ + ((size_t)bh * SEQ + part * 1024) * 128 + (lane >> 4) * 128 + (lane & 15) * 8; const bf16* kp = FK + ((size_t)bh * SEQ + part * 1024) * 128 + (lane >> 4) * 128 + (lane & 15) * 8;
        float mq = 0.f, mk = 0.f;
#pragma unroll 4
        for (int it = wave; it < 256; it += NWAVES) { const v4u a = *(const GAS v4u*)(qp + (size_t)it * 512), c = *(const GAS v4u*)(kp + (size_t)it * 512);
            float sq = 0.f, sk = 0.f;
#pragma unroll
            for (int e = 0; e < 4; ++e) { const float a0 = __builtin_bit_cast(float, a[e] << 16), a1 = __builtin_bit_cast(float, a[e] & 0xffff0000u), c0 = __builtin_bit_cast(float, c[e] << 16), c1 = __builtin_bit_cast(float, c[e] & 0xffff0000u);
                sq += a0 * a0 + a1 * a1; sk += c0 * c0 + c1 * c1; }
#pragma unroll
            for (int o = 1; o < 16; o <<= 1) { sq += __shfl_xor(sq, o); sk += __shfl_xor(sk, o); }
            mq = fmaxf(mq, sq); mk = fmaxf(mk, sk); }
#pragma unroll
        for (int o = 16; o < 64; o <<= 1) { mq = fmaxf(mq, __shfl_xor(mq, o)); mk = fmaxf(mk, __shfl_xor(mk, o)); }
        if (lane == 0) { atomicMax(nrm + bh, __builtin_bit_cast(unsigned, mq)); atomicMax(nrm + 64 + bh, __builtin_bit_cast(unsigned, mk)); } }
}
__device__ __forceinline__ void diffcomb_phase(const bf16* OD, bf16* YB, const float* lamp, const float* subln, int vcu, int G, int wave, int lane) {
    float s1 = lamp[lane] * lamp[128 + lane] + lamp[64 + lane] * lamp[192 + lane], s2 = lamp[256 + lane] * lamp[384 + lane] + lamp[320 + lane] * lamp[448 + lane];
    s1 = wave_sum(s1); s2 = wave_sum(s2);
    const float lam = __expf(s1) - __expf(s2) + 0.2f;
    const f32x4 g = *(const GAS f32x4*)(subln + 4 * lane) * 0.8f;
    const int gw = vcu * NWAVES + wave, NGW = G * NWAVES;
    for (int m = gw; m < M; m += NGW) { const bf16* orow = OD + (size_t)m * 4096; bf16* yrow = YB + (size_t)m * 2048;
#pragma unroll 4
        for (int h = 0; h < 8; ++h) { const unsigned long long a = *(const GAS unsigned long long*)(orow + h * 512 + 4 * lane), c = *(const GAS unsigned long long*)(orow + h * 512 + 256 + 4 * lane);
            f32x4 y;
            y.x = __builtin_bit_cast(float, (unsigned)(a << 16)) - lam * __builtin_bit_cast(float, (unsigned)(c << 16));
            y.y = __builtin_bit_cast(float, (unsigned)a & 0xffff0000u) - lam * __builtin_bit_cast(float, (unsigned)c & 0xffff0000u);
            y.z = __builtin_bit_cast(float, (unsigned)(a >> 32) << 16) - lam * __builtin_bit_cast(float, (unsigned)(c >> 32) << 16);
            y.w = __builtin_bit_cast(float, (unsigned)(a >> 32) & 0xffff0000u) - lam * __builtin_bit_cast(float, (unsigned)(c >> 32) & 0xffff0000u);
            const float r = 1.f / sqrtf(wave_sum((y.x * y.x + y.y * y.y) + (y.z * y.z + y.w * y.w)) * (1.f / 256.f) + RMS_EPS);
            y = y * r * g;
            *(GAS unsigned long long*)(yrow + h * 256 + 4 * lane) = (unsigned long long)pk2(y.x, y.y) | ((unsigned long long)pk2(y.z, y.w) << 32); } }
}

__device__ __forceinline__ att::BlockRef att_ref(unsigned char* ws, int j, int G, int cc) {
    const int Lp = (j >> 1) * G + cc, grp = Lp >> 3, xx = Lp & 7, qb = (j & 1) ? 15 - xx : xx;
    att::BlockRef r;
    const att::bf16* Q6 = (const att::bf16*)(ws + WS_QKV); const size_t TS = (size_t)M * 2048, HS = (size_t)SEQ * 128;
    if (grp < 64) { const int b = grp >> 4, h = grp & 15;
        r.Q = Q6 + (size_t)grp * HS + (size_t)qb * 256 * 128; r.K = Q6 + TS + (size_t)grp * HS; r.V = Q6 + 2 * TS + (size_t)grp * HS;
        r.O = (att::bf16*)(ws + WS_YA) + ((size_t)b * SEQ + qb * 256) * 2048 + h * 128; r.opitch = 2048; r.kb = (const float*)(ws + WS_KBIAS) + (size_t)grp * SEQ; r.CH = 0;
        { const unsigned* nrm = (const unsigned*)(ws + WS_NRM); const float B = sqrtf(__builtin_bit_cast(float, nrm[grp]) * __builtin_bit_cast(float, nrm[64 + grp]));
          const float th = 2.02f * B + 1250.f; const int lane = threadIdx.x & 63, nb = qb * 4;
          const float k0 = r.kb[qb * 256], kv = r.kb[(lane < nb ? lane : 0) * 64 + 63];
          const unsigned long long msk = __ballot(lane < nb && (k0 - kv) > th);
          r.jlo = __builtin_amdgcn_readfirstlane((int)__builtin_ctzll(~msk)); } }
    else { const int vh = grp - 64, b = vh >> 5, rr = vh & 31, h = rr >> 2, n = (rr >> 1) & 1, half = rr & 1;
        r.Q = Q6 + 3 * TS + (size_t)(b * 16 + h * 2 + n) * HS + (size_t)qb * 256 * 128; r.K = Q6 + 4 * TS + (size_t)(b * 16 + h * 2 + n) * HS; r.V = Q6 + 5 * TS + (size_t)(b * 16 + h * 2 + half) * HS;
        r.O = (att::bf16*)(ws + WS_ODIFF) + ((size_t)b * SEQ + qb * 256) * 4096 + h * 512 + n * 256 + half * 128; r.opitch = 4096; r.kb = nullptr; r.CH = 63; r.jlo = 0; }
    r.P0 = qb * 256; return r;
}
#define PH_BEGIN size_t ws_z = 0; asm volatile("" : "+s"(ws_z)); unsigned char* ws = args.ws + ws_z; int tid = threadIdx.x; asm volatile("" : "+v"(tid)); const int lane = tid & 63, wave = __builtin_amdgcn_readfirstlane(tid >> 6); (void)lane; (void)wave; (void)ws;
#define P_F32(off) ((float*)(ws + (off)))
#define P_BF(off) ((bf16*)(ws + (off)))
#define MODV P_F32(WS_MODV)
#define ROPEC P_F32(WS_ROPEC)
#define ROPES P_F32(WS_ROPES)
#define KBIAS P_F32(WS_KBIAS)
#define LOGF P_F32(WS_LOGF)
#define PART P_F32(WS_PART)
#define WFF P_BF(WS_WFF)
#define W1IN P_BF(WS_W1IN)
#define W1OUT P_BF(WS_W1OUT)
#define W2IN P_BF(WS_W2IN)
#define W2OUT P_BF(WS_W2OUT)
#define WIN P_BF(WS_WIN)
#define WOFOX P_BF(WS_WOFOX)
#define WODIFF P_BF(WS_WODIFF)
#define WOUT P_BF(WS_WOUT)
#define HB P_BF(WS_HB)
#define ACT P_BF(WS_BIG)
#define QKV P_BF(WS_QKV)
#define GATES P_BF(WS_GATES)
#define YA P_BF(WS_YA)
#define ODIFF P_BF(WS_ODIFF)
#define YB P_BF(WS_YB)
#define TMP P_BF(WS_TMP)
#define XS P_BF(WS_XS)
#define XIN ((const float*)args.in[0])
#define MV(k) (MODV + (k) * 16384)
struct Args { const void* in[23]; float* out; unsigned char* ws; };
__global__ void __launch_bounds__(NWAVES * 64, 2) mk_fwd(Args args) {
    extern __shared__ __attribute__((aligned(16))) unsigned char lds[];
    LAS unsigned char* L = (LAS unsigned char*)lds;
    volatile LAS unsigned* MISC = (volatile LAS unsigned*)(L + MISC_OFF);
    const int tid0 = threadIdx.x;
    const int G = gridDim.x; int vcu; { const int bx = blockIdx.x; vcu = (G % 8 == 0) ? (bx % 8) * (G / 8) + bx / 8 : bx; }
    gu32* ctl = (gu32*)(args.ws + WS_CTL);
    float* out = args.out;
    for (int u = tid0; u < (LDS_BYTES - LDSCTL_OFF) / 4; u += NWAVES * 64) ((LAS unsigned*)(L + LDSCTL_OFF))[u] = 0u;
    __syncthreads();
    XcdBarrier bar = xcd_barrier_post((unsigned*)(ctl + CW_BAR), MISC + 8);
#define GRID_BAR() xcd_barrier(bar)

    { PH_BEGIN
        const int gw = vcu * NWAVES + wave, NGW = G * NWAVES;
        const float* cvec = (const float*)args.in[1]; const int* pos = (const int*)args.in[2];
        LAS float* scr = (LAS float*)(L + RING_OFF + wave * 16384);
        constexpr int T_ADA = KCH * (NADA / 256), T_FADA = KCH * (NFADA / 256);
        constexpr int I_FIN = (DM / 64) * (NFF2 / 32), I_FOUT = (DFF / 64) * (DM / 32), I_WIN = (DM / 64) * ((INCOLS + 31) / 32), I_WO = (2048 / 64) * (DM / 32), I_WOUT = (DM / 64) * (DM / 32);
        constexpr int NITEMS = T_ADA + T_FADA + 2 * I_FIN + I_FOUT + I_WIN;
        for (int it = gw; it < NITEMS; it += NGW) {
            int r = it;
            if (r < T_ADA) { gemv_task((const float*)args.in[3], NADA, cvec, PART, 0, r, scr, lane); continue; } r -= T_ADA;
            if (r < T_FADA) { gemv_task((const float*)args.in[20], NFADA, cvec, PART, NADA, r, scr, lane); continue; } r -= T_FADA;
            if (r < I_FIN) { p0_transpose_item((const float*)args.in[6], DM, NFF2, MapGlu{W1IN}, scr, r, lane); continue; } r -= I_FIN;
            if (r < I_FOUT) { p0_transpose_item((const float*)args.in[7], DFF, DM, MapId{W1OUT, DFF}, scr, r, lane); continue; } r -= I_FOUT;
            if (r < I_WIN) { p0_transpose_item((const float*)args.in[9], DM, INCOLS, MapWin{WIN, WFF}, scr, r, lane); continue; } r -= I_WIN;
            p0_transpose_item((const float*)args.in[18], DM, NFF2, MapGlu{W2IN}, scr, r, lane);
        }
        for (int i = vcu * NWAVES * 64 + tid; i < M * 16; i += G * NWAVES * 64) { const int m = i >> 4, j = i & 15; float c, s; sincos_f64((float)pos[m] * c_inv_freq[j], c, s); ROPEC[i] = c; ROPES[i] = s; }
    }
    GRID_BAR();
    { PH_BEGIN
      for (int idx = vcu * NWAVES * 64 + tid; idx < 11 * 4 * DM; idx += G * NWAVES * 64) {
        const int q = idx >> 14, r = idx & 16383, b = r >> 12, col = r & 4095;
        const int ncol = q < 9 ? q * DM + col : NADA + (q - 9) * DM + col;
        float s = q < 9 ? ((const float*)args.in[4])[q * DM + col] : ((const float*)args.in[21])[(q - 9) * DM + col];
#pragma unroll 8
        for (int kc = 0; kc < KCH; ++kc) s += PART[(size_t)(kc * 4 + b) * NMODC + ncol];
        float o = s;
        if (q == 1) o = ((const float*)args.in[5])[col] * (1.f + s); else if (q == 4) o = ((const float*)args.in[8])[col] * (1.f + s); else if (q == 7) o = ((const float*)args.in[17])[col] * (1.f + s);
        else if (q == 10) o = ((const float*)args.in[22])[col] * (1.f + s); else if (q == 2 || q == 8) o = 0.5f * s;
        MODV[idx] = o;
      } }
    GRID_BAR();

#if ST_FFN1
    { PH_BEGIN norm_phase<false, false>(XIN, HB, MV(1), MV(0), L + RING_OFF, vcu, G, tid, wave, lane, false); }
    GRID_BAR();
    { PH_BEGIN pg8::Gemm g{HB, W1IN, M, NFF2, DM}; pg8::StaticOrder S; S.init(M, NFF2, G, (int)blockIdx.x); pg8::EpiSwiGLU E{ACT, DFF};
      pg8::gemm_phase<pg8::EpiSwiGLU, pg8::StaticOrder, true, true>(L + RING_OFF, g, S, E); }
    { PH_BEGIN const int nwg = (M / 256) * (NFF2 / 256), rem = nwg % G, c = (int)blockIdx.x;
      if (c >= rem) { const int pw = (c - rem) * NWAVES + wave, PW = (G - rem) * NWAVES; LAS float* scr = (LAS float*)(L + RING_OFF + wave * 16384);
        for (int it = pw; it < (DFF / 64) * (DM / 32); it += PW) p0_transpose_item((const float*)args.in[19], DFF, DM, MapId{W2OUT, DFF}, scr, it, lane);
        for (int it = pw; it < (DM / 64) * (DM / 32); it += PW) p0_transpose_item((const float*)args.in[16], DM, DM, MapId{WOUT, DM}, scr, it, lane);
        for (int it = pw; it < (2048 / 64) * (DM / 32); it += PW) { p0_transpose_item((const float*)args.in[14], 2048, DM, MapId{WOFOX, 2048}, scr, it, lane); p0_transpose_item((const float*)args.in[15], 2048, DM, MapId{WODIFF, 2048}, scr, it, lane); } } }
    GRID_BAR();
    { PH_BEGIN pg8::Gemm g{ACT, W1OUT, M, DM, DFF, 0, 1}; pg8::StaticOrder S; S.init(M, DM, G, (int)blockIdx.x); pg8::EpiResidB<true> E{XIN, XS, MV(2)};
      pg8::gemm_phase<pg8::EpiResidB<true>, pg8::StaticOrder, true, true>(L + RING_OFF, g, S, E); }
    GRID_BAR();
#else
    { PH_BEGIN for (size_t i = (size_t)(vcu * NWAVES * 64 + tid); i < (size_t)M * DM / 4; i += (size_t)G * NWAVES * 64) ((GAS f32x4*)out)[i] = ((const GAS f32x4*)XIN)[i]; }
    GRID_BAR();
#endif

#if ST_MIX
    { PH_BEGIN norm_phase<false, true>(XS, HB, MV(4), MV(3), L + RING_OFF, vcu, G, tid, wave, lane, false); }
    GRID_BAR();
#if !ST_P5
    { PH_BEGIN for (size_t i = (size_t)(vcu * NWAVES * 64 + tid); i < (size_t)M * 8192 * 2 / 16; i += (size_t)G * NWAVES * 64) ((GAS v4u*)GATES)[i] = (v4u){0x3f003f00u, 0x3f003f00u, 0x3f003f00u, 0x3f003f00u}; }
    GRID_BAR();
    GRID_BAR();
#else
    { PH_BEGIN pg8::Gemm g{HB, WIN, M, NPROJ, DM}; pg8::StaticOrder S; S.init(M, NPROJ, G, (int)blockIdx.x); pg8::EpiProj E{QKV, GATES, (const float*)args.in[11], ROPEC, ROPES};
      pg8::gemm_phase<pg8::EpiProj, pg8::StaticOrder, true, true>(L + RING_OFF, g, S, E); }
#if ST_FF
    { PH_BEGIN ff_phase(HB, WFF, (const float*)args.in[10], LOGF, vcu, G, wave, lane); }
#endif
    GRID_BAR();
#if ST_FF
    { PH_BEGIN qknorm_phase(QKV, QKV + (size_t)M * 2048, (unsigned*)(ws + WS_NRM), vcu, G, wave, lane);
      cumsum_phase(LOGF, KBIAS, L + RING_OFF, vcu, G, tid, wave, lane); }
#endif
    GRID_BAR();
#endif
#if !ST_ATT
    { PH_BEGIN for (size_t i = (size_t)(vcu * NWAVES * 64 + tid); i < (size_t)M * 2048 * 2 / 16; i += (size_t)G * NWAVES * 64) ((GAS v4u*)YA)[i] = (v4u){0u, 0u, 0u, 0u};
      for (size_t i = (size_t)(vcu * NWAVES * 64 + tid); i < (size_t)M * 4096 * 2 / 16; i += (size_t)G * NWAVES * 64) ((GAS v4u*)ODIFF)[i] = (v4u){0x3f803f80u, 0x3f803f80u, 0x3f803f80u, 0x3f803f80u}; }
#else
    { PH_BEGIN
        const int cc = (G % 8 == 0) ? ((int)blockIdx.x % 8) * (G / 8) + (int)blockIdx.x / 8 : (int)blockIdx.x;
        { constexpr int TOTAL = 64 * 8;
          const int nit = cc < TOTAL ? (TOTAL - 1 - cc) / G + 1 : 0;
          if (nit > 0) {
            att::Seam SM; att::BlockRef cur = att_ref(ws, 0, G, cc);
            att::block_prime(cur, (char*)lds + RING_OFF, SM);
            for (int j = 0; j < 2 * nit; ++j) { const att::BlockRef nxt = (j + 1 < 2 * nit) ? att_ref(ws, j + 1, G, cc) : cur;
                att::block_run(cur, nxt, (char*)lds + RING_OFF, SM); cur = nxt; } } }
        { constexpr int TOTAL2 = 32 * 16;
          for (int Lp = cc; Lp < TOTAL2; Lp += G) { const int g2 = Lp >> 4, xx = Lp & 15, b = g2 >> 3, h = g2 & 7;
            const att::bf16* Q6 = (const att::bf16*)(ws + WS_QKV); const size_t TS = (size_t)M * 2048, HS = (size_t)SEQ * 128;
            for (int pass = 0; pass < 4; ++pass) { const int qb = (pass & 1) ? xx : 31 - xx, n = pass >> 1;
                att2::DRef r; r.Q = Q6 + 3 * TS + (size_t)(b * 16 + h * 2 + n) * HS + (size_t)qb * 128 * 128; r.K = Q6 + 4 * TS + (size_t)(b * 16 + h * 2 + n) * HS;
                r.V0 = Q6 + 5 * TS + (size_t)(b * 16 + h * 2) * HS; r.V1 = r.V0 + HS;
                att::bf16* o1p = (att::bf16*)(ws + WS_ODIFF) + ((size_t)b * SEQ + qb * 128) * 4096 + h * 512;
                r.O = o1p; r.opitch = 4096; r.P0 = qb * 128; r.O1 = n ? o1p : nullptr;
                r.Y = (att::bf16*)(ws + WS_YB) + ((size_t)b * SEQ + qb * 128) * 2048 + h * 256; r.lamp = (const float*)args.in[12]; r.subln = (const float*)args.in[13]; r.desc = pass & 1;
                att2::diff_block(r, (char*)lds + RING_OFF, L + RING_OFF, (float*)((char*)lds + ATT2_XL_OFF)); } } }
    }
#endif
    GRID_BAR();
#if !ST_MA
    { PH_BEGIN for (size_t i = (size_t)(vcu * NWAVES * 64 + tid); i < (size_t)M * 4096 * 2 / 16; i += (size_t)G * NWAVES * 64) ((GAS v4u*)TMP)[i] = (v4u){0u, 0u, 0u, 0u}; }
    GRID_BAR();
#else
    { PH_BEGIN pg8::Gemm g{YA, WOFOX, M, DM, 2048}; pg8::StaticOrder S; S.init(M, DM, G, (int)blockIdx.x); pg8::EpiMerge<true> E{GATES, 0, nullptr, TMP};
      pg8::gemm_phase<pg8::EpiMerge<true>, pg8::StaticOrder, true, true>(L + RING_OFF, g, S, E); }
#endif
    { PH_BEGIN pg8::Gemm g{YB, WODIFF, M, DM, 2048}; pg8::StaticOrder S; S.init(M, DM, G, (int)blockIdx.x); pg8::EpiMerge<false> E{GATES, 4096, TMP, HB};
      pg8::gemm_phase<pg8::EpiMerge<false>, pg8::StaticOrder, true, true>(L + RING_OFF, g, S, E); }
    GRID_BAR();
    { PH_BEGIN pg8::Gemm g{HB, WOUT, M, DM, DM}; pg8::StaticOrder S; S.init(M, DM, G, (int)blockIdx.x); pg8::EpiResidB<false> E{XS, XS, MV(5)};
      pg8::gemm_phase<pg8::EpiResidB<false>, pg8::StaticOrder, true, true>(L + RING_OFF, g, S, E); }
    GRID_BAR();
#endif

#if ST_FFN2
    { PH_BEGIN norm_phase<false, true>(XS, HB, MV(7), MV(6), L + RING_OFF, vcu, G, tid, wave, lane, false); }
    GRID_BAR();
    { PH_BEGIN constexpr int NWG = (M / 256) * (NFF2 / 256);
      const bool split = (G % 2 == 0) && (NWG % G == G / 2);
      { pg8::Gemm g{HB, W2IN, M, NFF2, DM}; pg8::LimitedOrder S; S.init(M, NFF2, G, (int)blockIdx.x); S.maxi = split ? NWG / G : (NWG + G - 1) / G; pg8::EpiSwiGLU E{ACT, DFF};
        pg8::gemm_phase<pg8::EpiSwiGLU, pg8::LimitedOrder, true, true>(L + RING_OFF, g, S, E); }
      if (split) { const int c = (int)blockIdx.x, hc = G / 2, cu = c % hc; const bool helper = c >= hc;
        float* slab = P_F32(WS_TMP) + (size_t)cu * 65536; unsigned* flag = (unsigned*)(args.ws + WS_NRM + 4096) + 64 * cu;
        pg8::Gemm g{HB + (helper ? DM / 2 : 0), W2IN + (helper ? DM / 2 : 0), M, NFF2, DM / 2, DM};
        pg8::OneUnitOrder S; S.init(M, NFF2, G, c); S.round = NWG / G; S.cu = cu;
        if (helper) { pg8::EpiSlabStore E{slab, flag}; pg8::gemm_phase<pg8::EpiSlabStore, pg8::OneUnitOrder, true, true>(L + RING_OFF, g, S, E); }
        else { pg8::EpiSlabSwiGLU E{ACT, DFF, slab, flag, (unsigned*)(ctl + CW_BAR + XB_TMO)}; pg8::gemm_phase<pg8::EpiSlabSwiGLU, pg8::OneUnitOrder, true, true>(L + RING_OFF, g, S, E); } } }
    GRID_BAR();
    { PH_BEGIN pg8::Gemm g{ACT, W2OUT, M, DM, DFF, 0, 1}; pg8::StaticOrder S; S.init(M, DM, G, (int)blockIdx.x); pg8::EpiResidB<false> E{XS, XS, MV(8)};
      pg8::gemm_phase<pg8::EpiResidB<false>, pg8::StaticOrder, true, true>(L + RING_OFF, g, S, E); }
    GRID_BAR();
#endif
    { PH_BEGIN const bool poison = __hip_atomic_load((gu32*)(ctl + CW_BAR + XB_TMO), RLX_AGENT) != 0u;
      norm_phase<true, true>(XS, out, MV(10), MV(9), L + RING_OFF, vcu, G, tid, wave, lane, poison); }
}

extern "C" void kernel_launch(void* const* d_in, const int* in_sizes, int n_in, void* d_out, int out_size, void* d_ws, size_t ws_size, hipStream_t stream) {
    static int grid = 0;
    if (grid == 0) {
        if (n_in != 23 || in_sizes[0] != M * DM || out_size != M * DM || ws_size < WS_END) { fprintf(stderr, "kernel_launch: unexpected shapes (n_in %d, in0 %d, out %d, ws %zu < %zu); nothing launched\n", n_in, n_in > 0 ? in_sizes[0] : -1, out_size, ws_size, (size_t)WS_END); grid = -1; return; }
        int dev = 0, cus = 0, per_cu = 0;
        if (hipGetDevice(&dev) != hipSuccess || hipDeviceGetAttribute(&cus, hipDeviceAttributeMultiprocessorCount, dev) != hipSuccess) { fprintf(stderr, "kernel_launch: device query failed\n"); grid = -1; return; }
        if (hipFuncSetAttribute((const void*)mk_fwd, hipFuncAttributeMaxDynamicSharedMemorySize, LDS_BYTES) != hipSuccess) { fprintf(stderr, "kernel_launch: hipFuncSetAttribute failed\n"); grid = -1; return; }
        if (hipOccupancyMaxActiveBlocksPerMultiprocessor(&per_cu, (const void*)mk_fwd, NWAVES * 64, LDS_BYTES) != hipSuccess || per_cu < 1) fprintf(stderr, "kernel_launch: note: occupancy query reports %d workgroups per CU\n", per_cu);
        (void)hipGetLastError();
        grid = cus;
    }
    if (grid < 0) return;
    if (hipMemsetAsync((char*)d_ws + WS_CTL, 0, CTL_ZERO_BYTES, stream) != hipSuccess) { fprintf(stderr, "kernel_launch: memset failed\n"); return; }
    Args a{};
    for (int i = 0; i < 23; ++i) a.in[i] = d_in[i];
    a.out = (float*)d_out; a.ws = (unsigned char*)d_ws;
    hipLaunchKernelGGL(mk_fwd, dim3(grid), dim3(NWAVES * 64), LDS_BYTES, stream, a);
    const hipError_t le = hipPeekAtLastError();
    if (le != hipSuccess) fprintf(stderr, "kernel_launch: launch failed: %s\n", hipGetErrorName(le));
}
```
